# Optimizing an MI355X kernel written in HIP

```python
import jax, jax.numpy as jnp
from jax import lax
import numpy as np

D_MODEL = 1024
BATCH = 8
SEQ = 2048
DEPTH = 4
DEC_BATCH = 128
DEC_SEQ = 1
PAST_LEN = 8192
PAGE_SIZE = 128

N_A_LAYERS = DEPTH // 2
N_B_LAYERS = DEPTH - N_A_LAYERS
D_PLE = 256
D_FF = 2816
EPS = 1e-6
SSM_EXPAND = 2
D_INNER = SSM_EXPAND * D_MODEL
SSM_HEAD_DIM = 64
SSM_HEADS = D_INNER // SSM_HEAD_DIM
SSM_GROUPS = 8
HEADS_PER_GROUP = SSM_HEADS // SSM_GROUPS
D_STATE = 128
CONV_W = 4
CONV_DIM = D_INNER + 2 * SSM_GROUPS * D_STATE
SSD_CHUNK = 128
ATT_HEAD_DIM = 64
ATT_HEADS = D_MODEL // ATT_HEAD_DIM
ATT_KV_HEADS = 4
ATT_GROUP = ATT_HEADS // ATT_KV_HEADS
WINDOW = 128
Q_BLOCK = 128
ROPE_THETA = 10000.0

kernel_name = "yoco_mamba2_swa_sink_macaron_decoder_step"

F32 = jnp.float32


def rmsnorm(x, g):
    xf = x.astype(F32)
    y = xf * lax.rsqrt(jnp.mean(xf * xf, axis=-1, keepdims=True) + EPS)
    return (y * g.astype(F32)).astype(x.dtype)


def swiglu(x, wi, wo):
    gt, up = jnp.split(x @ wi, 2, axis=-1)
    return (jax.nn.silu(gt) * up) @ wo


def rope(x, pos):
    half = x.shape[-1] // 2
    inv = ROPE_THETA ** (-jnp.arange(half, dtype=F32) / half)
    ang = pos.astype(F32)[:, None] * inv[None, :]
    cos = jnp.cos(ang)[None, :, None, :]
    sin = jnp.sin(ang)[None, :, None, :]
    xf = x.astype(F32)
    x1, x2 = xf[..., :half], xf[..., half:]
    return jnp.concatenate([x1 * cos - x2 * sin, x2 * cos + x1 * sin], axis=-1).astype(x.dtype)


def ssd_scan(x, dt, a, bm, cm, h0):
    bsz, t_len = x.shape[:2]
    L = min(SSD_CHUNK, t_len)
    t_pad = -(-t_len // L) * L
    pad = t_pad - t_len
    if pad:
        def pw(arr):
            return jnp.pad(arr, [(0, 0), (0, pad)] + [(0, 0)] * (arr.ndim - 2))
        x, dt, bm, cm = pw(x), pw(dt), pw(bm), pw(cm)
    nc = t_pad // L
    G, E, P, N = SSM_GROUPS, HEADS_PER_GROUP, SSM_HEAD_DIM, D_STATE
    xf = x.astype(F32).reshape(bsz, nc, L, G, E, P)
    dtc = dt.astype(F32).reshape(bsz, nc, L, G, E)
    bc = bm.astype(F32).reshape(bsz, nc, L, G, N)
    cc = cm.astype(F32).reshape(bsz, nc, L, G, N)
    xdt = xf * dtc[..., None]
    cum = jnp.cumsum(dtc * a.reshape(G, E), axis=2)
    cum_t = jnp.moveaxis(cum, 2, -1)
    causal = jnp.tril(jnp.ones((L, L), dtype=bool))
    seg = cum_t[..., :, None] - cum_t[..., None, :]
    decay = jnp.exp(jnp.where(causal, seg, -jnp.inf))
    cb = jnp.einsum('bclgn,bcsgn->bcgls', cc, bc)
    y_intra = jnp.einsum('bcgels,bcsgep->bclgep', cb[:, :, :, None] * decay, xdt)
    cum_last = cum[:, :, -1]
    to_end = jnp.exp(cum_last[:, :, None] - cum)
    s_chunk = jnp.einsum('bclgn,bclgep->bcgepn', bc, xdt * to_end[..., None])

    def step(h, inp):
        s_c, dec_c = inp
        return h * dec_c[..., None, None] + s_c, h

    h_init = h0.astype(F32).reshape(bsz, G, E, P, N)
    h_last, h_in = lax.scan(step, h_init, (jnp.moveaxis(s_chunk, 1, 0), jnp.moveaxis(jnp.exp(cum_last), 1, 0)))
    h_in = jnp.moveaxis(h_in, 0, 1)
    y_inter = jnp.einsum('bclgn,bcgepn->bclgep', cc, h_in) * jnp.exp(cum)[..., None]
    y = (y_intra + y_inter).reshape(bsz, t_pad, SSM_HEADS, P)[:, :t_len]
    return y, h_last.reshape(bsz, SSM_HEADS, P, N)


def mamba2_mixer(u, w_in, conv_w, conv_b, dt_bias, a_log, d_skip, norm_g, w_out, ssm0, conv0):
    bsz, t_len, _ = u.shape
    z, xbc, dt_raw = jnp.split(u @ w_in, [D_INNER, D_INNER + CONV_DIM], axis=-1)
    xbc_full = jnp.concatenate([conv0.astype(xbc.dtype), xbc], axis=1)
    conv = conv_b + sum(xbc_full[:, k:k + t_len] * conv_w[k] for k in range(CONV_W))
    xbc_act = jax.nn.silu(conv)
    xs, bm, cm = jnp.split(xbc_act, [D_INNER, D_INNER + SSM_GROUPS * D_STATE], axis=-1)
    xs = xs.reshape(bsz, t_len, SSM_HEADS, SSM_HEAD_DIM)
    bm = bm.reshape(bsz, t_len, SSM_GROUPS, D_STATE)
    cm = cm.reshape(bsz, t_len, SSM_GROUPS, D_STATE)
    dt = jax.nn.softplus(dt_raw.astype(F32) + dt_bias.astype(F32))
    a = -jnp.exp(a_log.astype(F32))
    y, h_last = ssd_scan(xs, dt, a, bm, cm, ssm0)
    y = y + d_skip.astype(F32)[:, None] * xs.astype(F32)
    gated = y.reshape(bsz, t_len, D_INNER) * jax.nn.silu(z.astype(F32))
    gg = gated.reshape(bsz, t_len, SSM_GROUPS, D_INNER // SSM_GROUPS)
    gg = gg * lax.rsqrt(jnp.mean(gg * gg, axis=-1, keepdims=True) + EPS)
    out = (gg.reshape(bsz, t_len, D_INNER) * norm_g.astype(F32)).astype(u.dtype) @ w_out
    return out, h_last.astype(ssm0.dtype), xbc_full[:, -(CONV_W - 1):].astype(conv0.dtype)


def shared_kv(x, kv_norm, w_kv, k_norm, pos):
    bsz, t_len, _ = x.shape
    k, v = jnp.split(rmsnorm(x, kv_norm) @ w_kv, 2, axis=-1)
    k = k.reshape(bsz, t_len, ATT_KV_HEADS, ATT_HEAD_DIM)
    v = v.reshape(bsz, t_len, ATT_KV_HEADS, ATT_HEAD_DIM)
    return rope(rmsnorm(k, k_norm), pos), v


def window_attention(q, k_all, v_all, hist_valid, sinks):
    bsz, t_len = q.shape[:2]
    qb = Q_BLOCK if t_len % Q_BLOCK == 0 else t_len
    nb = t_len // qb
    kspan = qb + WINDOW
    starts = jnp.arange(nb) * qb
    kidx = starts[:, None] + jnp.arange(kspan)[None, :]
    tq = starts[:, None] + jnp.arange(qb)[None, :]
    kb = jnp.take(k_all, kidx, axis=1)
    vb = jnp.take(v_all, kidx, axis=1)
    qg = q.reshape(bsz, nb, qb, ATT_KV_HEADS, ATT_GROUP, ATT_HEAD_DIM)
    s = jnp.einsum('bnqkgd,bnskd->bnkgqs', qg, kb).astype(F32) * (ATT_HEAD_DIM ** -0.5)
    rel = (WINDOW + tq)[:, :, None] - kidx[:, None, :]
    mask = (rel >= 0) & (rel <= WINDOW)
    if not hist_valid:
        mask = mask & (kidx[:, None, :] >= WINDOW)
    s = jnp.where(mask[None, :, None, None], s, -jnp.inf)
    sink = jnp.broadcast_to(sinks.astype(F32).reshape(ATT_KV_HEADS, ATT_GROUP)[None, None, :, :, None, None], s.shape[:-1] + (1,))
    prob = jax.nn.softmax(jnp.concatenate([s, sink], axis=-1), axis=-1)[..., :-1]
    o = jnp.einsum('bnkgqs,bnskd->bnqkgd', prob.astype(vb.dtype), vb)
    return o.reshape(bsz, t_len, ATT_HEADS * ATT_HEAD_DIM)


def trunk(x, p, ssm0, conv0, k_hist, v_hist, pos0, hist_valid, w):
    bsz, t_len, _ = x.shape
    pos = pos0 + jnp.arange(t_len)
    new_ssm, new_conv = [], []
    k_all = v_all = None
    for i in range(DEPTH):
        x = x + 0.5 * swiglu(rmsnorm(x, w['ffn1_norm'][i]), w['ffn1_wi'][i], w['ffn1_wo'][i])
        h = rmsnorm(x, w['mix_norm'][i])
        if i < N_A_LAYERS:
            out, h_last, c_last = mamba2_mixer(h, w['ssm_in'][i], w['ssm_conv_w'][i], w['ssm_conv_b'][i], w['ssm_dt_bias'][i], w['ssm_a_log'][i], w['ssm_d'][i], w['ssm_norm'][i], w['ssm_out'][i], ssm0[i], conv0[i])
            new_ssm.append(h_last)
            new_conv.append(c_last)
        else:
            j = i - N_A_LAYERS
            q = (h @ w['w_q'][j]).reshape(bsz, t_len, ATT_HEADS, ATT_HEAD_DIM)
            q = rope(rmsnorm(q, w['q_norm'][j]), pos)
            out = window_attention(q, k_all, v_all, hist_valid, w['attn_sinks'][j]) @ w['w_o'][j]
        x = x + out
        x = x + 0.5 * swiglu(rmsnorm(x, w['ffn2_norm'][i]), w['ffn2_wi'][i], w['ffn2_wo'][i])
        gate = jax.nn.sigmoid(rmsnorm(x, w['ple_norm'][i]) @ w['ple_gate'][i])
        x = x + gate * (p[i] @ w['ple_proj'][i])
        if i == N_A_LAYERS - 1:
            k_new, v_new = shared_kv(x, w['kv_norm'], w['w_kv'], w['k_norm'], pos)
            k_all = jnp.concatenate([k_hist.astype(k_new.dtype), k_new], axis=1)
            v_all = jnp.concatenate([v_hist.astype(v_new.dtype), v_new], axis=1)
    return x, jnp.stack(new_ssm), jnp.stack(new_conv), k_all[:, -WINDOW:], v_all[:, -WINDOW:]


def setup_inputs(seed: int = 0) -> dict:
    key = jax.random.key(seed)
    ks = list(jax.random.split(key, 48))
    cnt = [0]

    def nk():
        cnt[0] += 1
        return ks[cnt[0] - 1]

    def nrm(shape, scale):
        return scale * jax.random.normal(nk(), shape, F32)

    def gain(shape):
        return 1.0 + nrm(shape, 0.02)

    dt0 = jnp.exp(jax.random.uniform(nk(), (N_A_LAYERS, SSM_HEADS), F32, np.log(1e-3), np.log(1e-1)))
    d = {
        'x_prompt': nrm((BATCH, SEQ, D_MODEL), 1.0),
        'x_sample': nrm((DEC_BATCH, DEC_SEQ, D_MODEL), 1.0),
        'state_ssm': nrm((N_A_LAYERS, DEC_BATCH, SSM_HEADS, SSM_HEAD_DIM, D_STATE), 0.5),
        'state_conv': nrm((N_A_LAYERS, DEC_BATCH, CONV_W - 1, CONV_DIM), 1.0),
        'cache_k': nrm((DEC_BATCH, WINDOW, ATT_KV_HEADS, ATT_HEAD_DIM), 1.0),
        'cache_v': nrm((DEC_BATCH, WINDOW, ATT_KV_HEADS, ATT_HEAD_DIM), 1.0),
        'p_prompt': nrm((DEPTH, BATCH, SEQ, D_PLE), 1.0),
        'p_sample': nrm((DEPTH, DEC_BATCH, DEC_SEQ, D_PLE), 1.0),
        'ffn1_norm': gain((DEPTH, D_MODEL)),
        'ffn1_wi': nrm((DEPTH, D_MODEL, 2 * D_FF), D_MODEL ** -0.5),
        'ffn1_wo': nrm((DEPTH, D_FF, D_MODEL), D_FF ** -0.5),
        'mix_norm': gain((DEPTH, D_MODEL)),
        'ffn2_norm': gain((DEPTH, D_MODEL)),
        'ffn2_wi': nrm((DEPTH, D_MODEL, 2 * D_FF), D_MODEL ** -0.5),
        'ffn2_wo': nrm((DEPTH, D_FF, D_MODEL), D_FF ** -0.5),
        'ple_norm': gain((DEPTH, D_MODEL)),
        'ple_gate': nrm((DEPTH, D_MODEL, D_MODEL), D_MODEL ** -0.5),
        'ple_proj': nrm((DEPTH, D_PLE, D_MODEL), D_PLE ** -0.5),
        'ssm_in': nrm((N_A_LAYERS, D_MODEL, D_INNER + CONV_DIM + SSM_HEADS), D_MODEL ** -0.5),
        'ssm_conv_w': nrm((N_A_LAYERS, CONV_W, CONV_DIM), CONV_W ** -0.5),
        'ssm_conv_b': nrm((N_A_LAYERS, CONV_DIM), 0.01),
        'ssm_dt_bias': dt0 + jnp.log(-jnp.expm1(-dt0)),
        'ssm_a_log': jnp.log(jax.random.uniform(nk(), (N_A_LAYERS, SSM_HEADS), F32, 1.0, 16.0)),
        'ssm_d': gain((N_A_LAYERS, SSM_HEADS)),
        'ssm_norm': gain((N_A_LAYERS, D_INNER)),
        'ssm_out': nrm((N_A_LAYERS, D_INNER, D_MODEL), D_INNER ** -0.5),
        'kv_norm': gain((D_MODEL,)),
        'w_kv': nrm((D_MODEL, 2 * ATT_KV_HEADS * ATT_HEAD_DIM), D_MODEL ** -0.5),
        'k_norm': gain((ATT_HEAD_DIM,)),
        'w_q': nrm((N_B_LAYERS, D_MODEL, ATT_HEADS * ATT_HEAD_DIM), D_MODEL ** -0.5),
        'q_norm': gain((N_B_LAYERS, ATT_HEAD_DIM)),
        'attn_sinks': nrm((N_B_LAYERS, ATT_HEADS), 1.0),
        'w_o': nrm((N_B_LAYERS, ATT_HEADS * ATT_HEAD_DIM, D_MODEL), (ATT_HEADS * ATT_HEAD_DIM) ** -0.5),
    }
    return d


def reference(x_prompt, x_sample, state_ssm, state_conv, cache_k, cache_v, p_prompt, p_sample,
              ffn1_norm, ffn1_wi, ffn1_wo, mix_norm, ffn2_norm, ffn2_wi, ffn2_wo,
              ple_norm, ple_gate, ple_proj,
              ssm_in, ssm_conv_w, ssm_conv_b, ssm_dt_bias, ssm_a_log, ssm_d, ssm_norm, ssm_out,
              kv_norm, w_kv, k_norm, w_q, q_norm, attn_sinks, w_o):
    w = {'ffn1_norm': ffn1_norm, 'ffn1_wi': ffn1_wi, 'ffn1_wo': ffn1_wo, 'mix_norm': mix_norm,
         'ffn2_norm': ffn2_norm, 'ffn2_wi': ffn2_wi, 'ffn2_wo': ffn2_wo,
         'ple_norm': ple_norm, 'ple_gate': ple_gate, 'ple_proj': ple_proj,
         'ssm_in': ssm_in, 'ssm_conv_w': ssm_conv_w, 'ssm_conv_b': ssm_conv_b, 'ssm_dt_bias': ssm_dt_bias,
         'ssm_a_log': ssm_a_log, 'ssm_d': ssm_d, 'ssm_norm': ssm_norm, 'ssm_out': ssm_out,
         'kv_norm': kv_norm, 'w_kv': w_kv, 'k_norm': k_norm, 'w_q': w_q, 'q_norm': q_norm,
         'attn_sinks': attn_sinks, 'w_o': w_o}
    bp = x_prompt.shape[0]
    ssm0_p = jnp.zeros((N_A_LAYERS, bp, SSM_HEADS, SSM_HEAD_DIM, D_STATE), x_prompt.dtype)
    conv0_p = jnp.zeros((N_A_LAYERS, bp, CONV_W - 1, CONV_DIM), x_prompt.dtype)
    kv0_p = jnp.zeros((bp, WINDOW, ATT_KV_HEADS, ATT_HEAD_DIM), x_prompt.dtype)
    y_prompt, ssm_p, conv_p, k_p, v_p = trunk(x_prompt, p_prompt, ssm0_p, conv0_p, kv0_p, kv0_p, 0, False, w)
    y_sample, ssm_s, conv_s, k_s, v_s = trunk(x_sample, p_sample, state_ssm, state_conv, cache_k, cache_v, PAST_LEN, True, w)
    return (y_prompt, y_sample, ssm_p, conv_p, k_p, v_p, ssm_s, conv_s, k_s, v_s)
```

```cpp
#include <hip/hip_runtime.h>
#include <hip/hip_cooperative_groups.h>
#include <cstdio>
#include <cstdint>
namespace cg = cooperative_groups;
namespace pg8 {
#define PG8_LAS __attribute__((address_space(3)))
typedef unsigned short bf16_t;
typedef short bf16x8 __attribute__((ext_vector_type(8)));
typedef float f32x4 __attribute__((ext_vector_type(4)));
typedef unsigned u32x4 __attribute__((ext_vector_type(4)));
constexpr int BM = 256, BK = 64, HALF = 128, HTB = HALF * BK * 2  , STAGE_BYTES = 8 * HTB, NXCD = 8, WGM = 8;

__host__ __device__ __forceinline__ int lds_byte(int r, int c) { const int st = (r >> 4) * 2 + (c >> 5), rr = r & 15, cc = c & 31, ob = rr * 64 + cc * 2; return st * 1024 + (ob ^ (((ob >> 9) & 1) << 5)); }
__host__ __device__ __forceinline__ void stage_rc(int b, int& R, int& C) { const int st = b / 1024, sb = b % 1024, swz = sb ^ (((sb >> 9) & 1) << 5); R = (st >> 1) * 16 + swz / 64; C = (st & 1) * 32 + (swz % 64) / 2; }
__host__ __device__ __forceinline__ int perm32(int rho) { const int n = rho >> 4, i = rho & 15; return 8 * (i >> 2) + 4 * n + (i & 3); }

struct Unit { int pm, pn; };
struct Gemm { const bf16_t* A; const bf16_t* Bt; int M, N, K; };

struct StaticOrder {
    int nM, nN, nwg, G, c;
    __host__ __device__ void init(int M, int N, int G_, int c_) { nM = M / BM; nN = N / BM; nwg = nM * nN; G = G_; c = c_; }
    __host__ __device__ bool next(int i, Unit& u) const {
        const long L = (long)i * G + c; if (L >= nwg) return false;
        int wgid = (int)L; { const int q = nwg / NXCD, r = nwg % NXCD, xcd = wgid % NXCD, off = wgid / NXCD; wgid = (xcd < r ? xcd * (q + 1) : r * (q + 1) + (xcd - r) * q) + off; }
        const int nig = WGM * nN, gid = wgid / nig, fm = gid * WGM, gsz = (nM - fm) < WGM ? (nM - fm) : WGM;
        u.pm = fm + ((wgid % nig) % gsz); u.pn = (wgid % nig) / gsz; return true;
    }
    __device__ __forceinline__ void a_ready(const Unit&) const {}
    __device__ __forceinline__ void done(const Unit&) const {}
};


typedef float f32x2_t __attribute__((ext_vector_type(2)));
typedef __bf16 bf16x2_t __attribute__((ext_vector_type(2)));
__device__ __forceinline__ unsigned cvt_pk_bf16(float lo, float hi) { f32x2_t v = {lo, hi}; bf16x2_t b = __builtin_convertvector(v, bf16x2_t); return __builtin_bit_cast(unsigned, b); }
typedef unsigned u32x2 __attribute__((ext_vector_type(2)));
constexpr float RMS_EPS = 1e-6f;
__device__ __forceinline__ float rstd_row(const float* SS, int row) {
    const f32x4* p = (const f32x4*)(SS + (size_t)row * 16);
    const f32x4 a = p[0], b = p[1], c = p[2], d = p[3];
    const float s = ((a[0] + a[1]) + (a[2] + a[3])) + ((b[0] + b[1]) + (b[2] + b[3])) + ((c[0] + c[1]) + (c[2] + c[3])) + ((d[0] + d[1]) + (d[2] + d[3]));
    return __builtin_amdgcn_rsqf(s * (1.0f / 1024.0f) + RMS_EPS);
}
__device__ __forceinline__ float sigmoid_f(float v) { return __builtin_amdgcn_rcpf(1.0f + __expf(-v)); }

struct EpiSwiGLU {
    static constexpr bool PERM = true, AFTER_DRAIN = false;
    bf16_t* H; int ldh; const float* SS;
    __device__ __forceinline__ void operator()(const f32x4 (&acc)[2][2][4][2], const Unit& u, int wr, int wc, int fr, int fq) const {
        const int row0 = u.pm * BM + wr * 64 + fr; const int col0 = u.pn * 128 + wc * 32 + 8 * fq;
#pragma unroll
        for (int ai = 0; ai < 2; ++ai)
#pragma unroll
            for (int m = 0; m < 4; ++m) {
                const int row = row0 + ai * HALF + m * 16; const float rs = rstd_row(SS, row);
                float h[8];
#pragma unroll
                for (int n = 0; n < 2; ++n)
#pragma unroll
                    for (int e = 0; e < 4; ++e) { const float g = acc[ai][0][m][n][e] * rs, up = acc[ai][1][m][n][e] * rs; h[n * 4 + e] = g * sigmoid_f(g) * up; }
                u32x4 w; w.x = cvt_pk_bf16(h[0], h[1]); w.y = cvt_pk_bf16(h[2], h[3]); w.z = cvt_pk_bf16(h[4], h[5]); w.w = cvt_pk_bf16(h[6], h[7]);
                *(u32x4*)(H + (size_t)row * ldh + col0) = w;
            }
    }
};
struct EpiSplit {
    static constexpr bool PERM = true, AFTER_DRAIN = false;
    bf16_t* O0; int ld0; int t1; bf16_t* O1; int ld1; int t2; float* DT; const float* SS;
    __device__ __forceinline__ void operator()(const f32x4 (&acc)[2][2][4][2], const Unit& u, int wr, int wc, int fr, int fq) const {
        const int row0 = u.pm * BM + wr * 64 + fr;
        bf16_t* base; int ld, colt;
        if (u.pn < t1) { base = O0; ld = ld0; colt = u.pn * BM; } else { base = O1; ld = ld1; colt = (u.pn - t1) * BM; }
        const bool isdt = u.pn >= t2;
        const int col0 = colt + wc * 32 + 8 * fq;
#pragma unroll
        for (int ai = 0; ai < 2; ++ai)
#pragma unroll
            for (int m = 0; m < 4; ++m) {
                const int row = row0 + ai * HALF + m * 16; const float rs = rstd_row(SS, row);
                if (!isdt) {
#pragma unroll
                    for (int bj = 0; bj < 2; ++bj) { const f32x4 v0 = acc[ai][bj][m][0] * rs, v1 = acc[ai][bj][m][1] * rs;
                        u32x4 w; w.x = cvt_pk_bf16(v0[0], v0[1]); w.y = cvt_pk_bf16(v0[2], v0[3]); w.z = cvt_pk_bf16(v1[0], v1[1]); w.w = cvt_pk_bf16(v1[2], v1[3]);
                        *(u32x4*)(base + (size_t)row * ld + col0 + bj * HALF) = w; }
                } else if (wc == 0) {
                    float* d = DT + (size_t)row * 32 + 8 * fq;
                    *(f32x4*)d = acc[ai][0][m][0] * rs; *(f32x4*)(d + 4) = acc[ai][0][m][1] * rs;
                }
            }
    }
};
struct EpiF32 {
    static constexpr bool PERM = false, AFTER_DRAIN = false;
    float* O; int ldo; const float* SS; bf16_t* OB;
    __device__ __forceinline__ void operator()(const f32x4 (&acc)[2][2][4][2], const Unit& u, int wr, int wc, int fr, int fq) const {
        const int row0 = u.pm * BM + wr * 64 + fr; const int col0 = u.pn * BM + wc * 32 + 4 * fq;
#pragma unroll
        for (int ai = 0; ai < 2; ++ai)
#pragma unroll
            for (int m = 0; m < 4; ++m) {
                const int row = row0 + ai * HALF + m * 16; const float rs = SS ? rstd_row(SS, row) : 1.0f;
#pragma unroll
                for (int bj = 0; bj < 2; ++bj)
#pragma unroll
                    for (int n = 0; n < 2; ++n) { const f32x4 v = acc[ai][bj][m][n] * rs; const size_t o_ = (size_t)row * ldo + col0 + bj * HALF + n * 16;
                        if (OB) { u32x2 w; w.x = cvt_pk_bf16(v[0], v[1]); w.y = cvt_pk_bf16(v[2], v[3]); *(u32x2*)(OB + o_) = w; } else *(f32x4*)(O + o_) = v; }
            }
    }
};
struct EpiRes {
    static constexpr bool PERM = false, AFTER_DRAIN = false;
    const bf16_t* XBin; float* Xout; bf16_t* XB; float* SSout; const float* SSin; const bf16_t* PP; float scale; int mode; int mreal;
    __device__ __forceinline__ void operator()(const f32x4 (&acc)[2][2][4][2], const Unit& u, int wr, int wc, int fr, int fq) const {
        const int row0 = u.pm * BM + wr * 64 + fr; const int col0 = u.pn * BM + wc * 32 + 4 * fq;
#pragma unroll
        for (int ai = 0; ai < 2; ++ai)
#pragma unroll
            for (int m = 0; m < 4; ++m) {
                const int row = row0 + ai * HALF + m * 16; const size_t off = (size_t)row * 1024 + col0;
                const float rs = (mode == 1) ? rstd_row(SSin, row) : 0.0f;
                float ssq = 0.f;
#pragma unroll
                for (int bj = 0; bj < 2; ++bj)
#pragma unroll
                    for (int n = 0; n < 2; ++n) {
                        const u32x2 xb = *(const u32x2*)(XBin + off + bj * HALF + n * 16); const f32x4 a = acc[ai][bj][m][n];
                        f32x4 x4 = (f32x4){__uint_as_float(xb.x << 16), __uint_as_float(xb.x & 0xffff0000u), __uint_as_float(xb.y << 16), __uint_as_float(xb.y & 0xffff0000u)};
                        if (mode == 1) { const u32x2 pw = *(const u32x2*)(PP + off + bj * HALF + n * 16);
                            const f32x4 p4 = (f32x4){__uint_as_float(pw.x << 16), __uint_as_float(pw.x & 0xffff0000u), __uint_as_float(pw.y << 16), __uint_as_float(pw.y & 0xffff0000u)};
#pragma unroll
                            for (int e = 0; e < 4; ++e) x4[e] += sigmoid_f(a[e] * rs) * p4[e];
                        } else x4 += a * scale;
                        ssq += (x4[0] * x4[0] + x4[1] * x4[1]) + (x4[2] * x4[2] + x4[3] * x4[3]);
                        if (Xout) *(f32x4*)(Xout + off + bj * HALF + n * 16) = x4;
                        u32x2 w; w.x = cvt_pk_bf16(x4[0], x4[1]); w.y = cvt_pk_bf16(x4[2], x4[3]); *(u32x2*)(XB + off + bj * HALF + n * 16) = w;
                    }
                ssq += __shfl_xor(ssq, 16); ssq += __shfl_xor(ssq, 32);
                if (fq == 0) SSout[(size_t)row * 16 + u.pn * 4 + wc] = ssq;
                if (m & 1) asm volatile("" ::: "memory");
            }
    }
};

template <class Epi, class Sched, bool ALIGN_EPI = false, bool SP2 = false>
__device__ __forceinline__ void gemm_phase(PG8_LAS unsigned char* lds, const Gemm g, const Sched& S, const Epi& E, int tid_in) {
    int tid_l = tid_in; asm volatile("" : "+v"(tid_l));
    const int tid = tid_l, wid = __builtin_amdgcn_readfirstlane(tid >> 6), lane = tid & 63, wr = wid >> 2, wc = wid & 3, fr = lane & 15, fq = lane >> 4;
    const int K = g.K, nt = K / BK;
    unsigned voffA[2], voffB[2];
#pragma unroll
    for (int i = 0; i < 2; ++i) { int R, C; stage_rc(tid * 16 + i * 8192, R, C); const int Rb = Epi::PERM ? ((R & ~31) + perm32(R & 31)) : R;
        voffA[i] = (unsigned)(R * K + C) * 2u; voffB[i] = (unsigned)(Rb * K + C) * 2u; }
    const size_t kstep = (size_t)(BK * 2);
    const size_t hstep = (size_t)HALF * K * 2;
    const size_t tstep = 2 * hstep;
    const unsigned ldsw = (unsigned)wid * 1024u;
    const int aoff = lds_byte(wr * 64 + fr, fq * 8), boff = lds_byte(wc * 32 + fr, fq * 8);
#define PG8_SA(b, h) (((b) * 2 + (h)) * HTB)
#define PG8_SB(b, h) ((4 + (b) * 2 + (h)) * HTB)
#define PG8_STAGE(bufoff, gbase, voff) do { _Pragma("unroll") for (int _i = 0; _i < 2; ++_i) \
        __builtin_amdgcn_global_load_lds((const unsigned*)((const char*)(gbase) + (voff)[_i]), (PG8_LAS unsigned*)(lds + (bufoff) + ldsw + _i * 8192), 16, 0, 0); } while (0)
#define PG8_LDA(dst, b, h) do { _Pragma("unroll") for (int m = 0; m < 4; ++m) _Pragma("unroll") for (int k = 0; k < 2; ++k) dst[m][k] = *(const PG8_LAS bf16x8*)(lds + PG8_SA(b, h) + aoff + m * 2048 + k * 1024); } while (0)
#define PG8_LDB(dst, b, h) do { _Pragma("unroll") for (int n = 0; n < 2; ++n) _Pragma("unroll") for (int k = 0; k < 2; ++k) dst[n][k] = *(const PG8_LAS bf16x8*)(lds + PG8_SB(b, h) + boff + n * 2048 + k * 1024); } while (0)
#define PG8_MMA(ai, bj, At, Bt) do { __builtin_amdgcn_s_setprio(1); _Pragma("unroll") for (int m = 0; m < 4; ++m) _Pragma("unroll") for (int n = 0; n < 2; ++n) _Pragma("unroll") for (int k = 0; k < 2; ++k) \
        acc[ai][bj][m][n] = __builtin_amdgcn_mfma_f32_16x16x32_bf16(Bt[n][k], At[m][k], acc[ai][bj][m][n], 0, 0, 0); __builtin_amdgcn_s_setprio(0); } while (0)
#define PG8_WAIT_V(n) asm volatile("s_waitcnt vmcnt(" #n ")" ::: "memory")
#define PG8_WAIT_L(n) asm volatile("s_waitcnt lgkmcnt(" #n ")" ::: "memory")
#define PG8_BAR __builtin_amdgcn_s_barrier()
#define PG8_SCHED __builtin_amdgcn_sched_barrier(0)
    Unit cur, nxt; int ui = 0;
    if (!S.next(0, cur)) return;
    f32x4 acc[2][2][4][2];
#pragma unroll
    for (int a = 0; a < 2; ++a)
#pragma unroll
        for (int b = 0; b < 2; ++b)
#pragma unroll
            for (int m = 0; m < 4; ++m)
#pragma unroll
                for (int n = 0; n < 2; ++n) acc[a][b][m][n] = (f32x4){0.f, 0.f, 0.f, 0.f};
    bf16x8 At[4][2], B0[2][2], B1[2][2];
    const char* cA = (const char*)g.A + (size_t)cur.pm * tstep; const char* cB = (const char*)g.Bt + (size_t)cur.pn * tstep;
    S.a_ready(cur);
    if constexpr (SP2) {
        PG8_STAGE(PG8_SB(0, 0), cB, voffB); PG8_STAGE(PG8_SB(0, 1), cB + hstep, voffB); PG8_STAGE(PG8_SA(0, 0), cA, voffA); PG8_STAGE(PG8_SA(0, 1), cA + hstep, voffA);
        if (wr == 1) PG8_BAR;
        PG8_WAIT_V(2); PG8_BAR;
        PG8_STAGE(PG8_SB(1, 0), cB + kstep, voffB); PG8_STAGE(PG8_SA(1, 0), cA + kstep, voffA); PG8_STAGE(PG8_SB(1, 1), cB + hstep + kstep, voffB);
        PG8_WAIT_V(6); PG8_BAR;
    } else {
        PG8_STAGE(PG8_SB(0, 0), cB, voffB); PG8_STAGE(PG8_SA(0, 0), cA, voffA); PG8_STAGE(PG8_SB(0, 1), cB + hstep, voffB); PG8_STAGE(PG8_SA(0, 1), cA + hstep, voffA);
        if (wr == 1) PG8_BAR;
        PG8_WAIT_V(4); PG8_BAR;
        PG8_STAGE(PG8_SB(1, 0), cB + kstep, voffB); PG8_STAGE(PG8_SA(1, 0), cA + kstep, voffA); PG8_STAGE(PG8_SB(1, 1), cB + hstep + kstep, voffB);
        PG8_WAIT_V(6); PG8_BAR;
    }
    for (;;) {
        const bool has_next = S.next(ui + 1, nxt);
        const char* nA = has_next ? (const char*)g.A + (size_t)nxt.pm * tstep : cA; const char* nB = has_next ? (const char*)g.Bt + (size_t)nxt.pn * tstep : cB;
        for (int t = 0; t < nt; t += 2) {
            const bool last = (t == nt - 2);
            const char* a1 = cA + (size_t)(t + 1) * kstep;
            const char* a2 = last ? nA : cA + (size_t)(t + 2) * kstep; const char* b2 = last ? nB : cB + (size_t)(t + 2) * kstep;
            const char* a3 = a2 + kstep; const char* b3 = b2 + kstep;
            if (last && has_next) S.a_ready(nxt);
            if constexpr (SP2) {
            PG8_LDB(B0, 0, 0); PG8_LDB(B1, 0, 1); PG8_SCHED; PG8_LDA(At, 0, 0); PG8_STAGE(PG8_SA(1, 1), a1 + hstep, voffA);
            PG8_WAIT_V(8); PG8_WAIT_L(0); PG8_BAR; PG8_MMA(0, 0, At, B0); PG8_MMA(0, 1, At, B1); PG8_BAR; PG8_SCHED;
            PG8_LDA(At, 0, 1); PG8_STAGE(PG8_SB(0, 0), b2, voffB); PG8_STAGE(PG8_SB(0, 1), b2 + hstep, voffB); PG8_STAGE(PG8_SA(0, 0), a2, voffA);
            PG8_WAIT_V(8); PG8_WAIT_L(0); PG8_BAR; PG8_MMA(1, 0, At, B0); PG8_MMA(1, 1, At, B1); PG8_BAR; PG8_SCHED;
            PG8_LDB(B0, 1, 0); PG8_LDB(B1, 1, 1); PG8_SCHED; PG8_LDA(At, 1, 0); PG8_STAGE(PG8_SA(0, 1), a2 + hstep, voffA);
            PG8_WAIT_V(8); PG8_WAIT_L(0); PG8_BAR; PG8_MMA(0, 0, At, B0); PG8_MMA(0, 1, At, B1); PG8_BAR; PG8_SCHED;
            PG8_LDA(At, 1, 1); PG8_STAGE(PG8_SB(1, 0), b3, voffB); PG8_STAGE(PG8_SB(1, 1), b3 + hstep, voffB); PG8_STAGE(PG8_SA(1, 0), a3, voffA);
            PG8_WAIT_V(8); PG8_WAIT_L(0); PG8_BAR; PG8_MMA(1, 0, At, B0); PG8_MMA(1, 1, At, B1); PG8_BAR; PG8_SCHED;
            } else {
            PG8_LDB(B0, 0, 0); PG8_SCHED; PG8_LDA(At, 0, 0); PG8_STAGE(PG8_SA(1, 1), a1 + hstep, voffA);
            PG8_WAIT_L(8); PG8_BAR; PG8_WAIT_L(0); PG8_MMA(0, 0, At, B0); PG8_BAR; PG8_SCHED;
            PG8_LDB(B1, 0, 1); PG8_STAGE(PG8_SB(0, 0), b2, voffB);
            PG8_BAR; PG8_WAIT_L(0); PG8_MMA(0, 1, At, B1); PG8_BAR;
            PG8_LDA(At, 0, 1); PG8_STAGE(PG8_SA(0, 0), a2, voffA);
            PG8_BAR; PG8_WAIT_L(0); PG8_MMA(1, 0, At, B0); PG8_BAR; PG8_SCHED;
            PG8_STAGE(PG8_SB(0, 1), b2 + hstep, voffB);
            PG8_WAIT_V(6); PG8_BAR; PG8_MMA(1, 1, At, B1); PG8_BAR;
            PG8_LDB(B0, 1, 0); PG8_SCHED; PG8_LDA(At, 1, 0); PG8_STAGE(PG8_SA(0, 1), a2 + hstep, voffA);
            PG8_WAIT_L(8); PG8_BAR; PG8_WAIT_L(0); PG8_MMA(0, 0, At, B0); PG8_BAR; PG8_SCHED;
            PG8_LDB(B1, 1, 1); PG8_STAGE(PG8_SB(1, 0), b3, voffB);
            PG8_BAR; PG8_WAIT_L(0); PG8_MMA(0, 1, At, B1); PG8_BAR;
            PG8_LDA(At, 1, 1); PG8_STAGE(PG8_SA(1, 0), a3, voffA);
            PG8_BAR; PG8_WAIT_L(0); PG8_MMA(1, 0, At, B0); PG8_BAR; PG8_SCHED;
            PG8_STAGE(PG8_SB(1, 1), b3 + hstep, voffB);
            PG8_WAIT_V(6); PG8_BAR; PG8_MMA(1, 1, At, B1); PG8_BAR;
            }
        }
        if constexpr (ALIGN_EPI) { if (wr == 0) PG8_BAR; }
        if constexpr (!Epi::AFTER_DRAIN) { E(acc, cur, wr, wc, fr, fq); S.done(cur); }
        if (!has_next) break;
#pragma unroll
        for (int a = 0; a < 2; ++a)
#pragma unroll
            for (int b = 0; b < 2; ++b)
#pragma unroll
                for (int m = 0; m < 4; ++m)
#pragma unroll
                    for (int n = 0; n < 2; ++n) acc[a][b][m][n] = (f32x4){0.f, 0.f, 0.f, 0.f};
        cur = nxt; cA = nA; cB = nB; ++ui;
        if constexpr (ALIGN_EPI) { if (wr == 1) PG8_BAR; }
    }
    PG8_WAIT_V(0);
    if constexpr (!ALIGN_EPI) { if (wr == 0) PG8_BAR; }
    PG8_BAR;
    if constexpr (Epi::AFTER_DRAIN) { E.fused(acc, cur, wr, wc, fr, fq, lds, wid, lane); S.done(cur); }
#undef PG8_SA
#undef PG8_SB
#undef PG8_STAGE
#undef PG8_LDA
#undef PG8_LDB
#undef PG8_MMA
#undef PG8_WAIT_V
#undef PG8_WAIT_L
#undef PG8_BAR
#undef PG8_SCHED
}
}

#define LAS __attribute__((address_space(3)))
#define XB_TMO      128
#define XB_XCNT(j)  (256  + 64 * (j))
#define XB_XSUB(j)  (1280 + 64 * (j))
#define XB_XGEN(j)  (2304 + 64 * (j))
#define XB_TOP      3328
#define XB_TOPGEN   3392
#define XCD_BAR_WORDS 3456
#define XB_SPIN_CAP (1u << 18)

__device__ __forceinline__ unsigned xb_ld(unsigned* p)              { return __hip_atomic_load(p, __ATOMIC_RELAXED, __HIP_MEMORY_SCOPE_AGENT); }
__device__ __forceinline__ unsigned xb_add(unsigned* p, unsigned v) { return __hip_atomic_fetch_add(p, v, __ATOMIC_RELAXED, __HIP_MEMORY_SCOPE_AGENT); }
__device__ __forceinline__ unsigned xb_xcc_id() { return (unsigned)__builtin_amdgcn_s_getreg((3 << 11) | 20) & 0xFu; }
#define XB_SPIN(cond, bar) do { unsigned _sp = 0; while (cond) { __builtin_amdgcn_s_sleep(1); \
    if ((++_sp & 255u) == 0u) { if (xb_ld(&(bar)[XB_TMO])) break; if (_sp > XB_SPIN_CAP) { atomicAdd(&(bar)[XB_TMO], 1u); break; } } } } while (0)

struct XcdBarrier {
    unsigned* bar; unsigned x;
    volatile LAS unsigned* st;
};

__device__ __forceinline__ XcdBarrier xcd_barrier_post(unsigned* bar, volatile LAS unsigned* st, int tid) {
    XcdBarrier b; b.bar = bar; b.x = xb_xcc_id(); b.st = st;
    if (tid == 0) (void)xb_add(&bar[XB_XCNT(b.x)], 1u);
    return b;
}
__device__ __forceinline__ void xcd_barrier_complete(unsigned* bar, unsigned x, unsigned& nloc, unsigned& nx) {
    const unsigned G = gridDim.x * gridDim.y * gridDim.z;
    unsigned sum, cnt, mine, sp = 0u;
    for (;;) {
        sum = 0u; cnt = 0u; mine = 0u;
#pragma unroll
        for (unsigned j = 0; j < 16; ++j) { const unsigned c = xb_ld(&bar[XB_XCNT(j)]); sum += c; cnt += (c > 0u) ? 1u : 0u; mine = (j == x) ? c : mine; }
        if (sum == G) break;
        __builtin_amdgcn_s_sleep(1);
        if ((++sp & 255u) == 0u) { if (xb_ld(&bar[XB_TMO])) break; if (sp > XB_SPIN_CAP) { atomicAdd(&bar[XB_TMO], 1u); break; } }
    }
    nloc = mine > 0u ? mine : 1u; nx = cnt > 0u ? cnt : 1u;
}

__device__ __forceinline__ void xcd_barrier(const XcdBarrier& b, int tid) {
    asm volatile("s_waitcnt vmcnt(0)" ::: "memory");
    __syncthreads();
    if (tid == 0) {
        unsigned* bar = b.bar;
        __builtin_amdgcn_s_waitcnt(0);
        unsigned nloc = b.st[0], nx = b.st[1];
        if (nloc == 0u) { xcd_barrier_complete(bar, b.x, nloc, nx); b.st[0] = nloc; b.st[1] = nx; }
        const unsigned old = xb_add(&bar[XB_XSUB(b.x)], 1u);
        const unsigned gen = old / nloc;
        if (old + 1u == (gen + 1u) * nloc) {
            __builtin_amdgcn_fence(__ATOMIC_RELEASE, "agent");
            asm volatile("s_waitcnt vmcnt(0)" ::: "memory");
            const unsigned og = xb_add(&bar[XB_TOP], 1u);
            const unsigned tg = og / nx;
            if (og + 1u == (tg + 1u) * nx) xb_add(&bar[XB_TOPGEN], 1u);
            else XB_SPIN(xb_ld(&bar[XB_TOPGEN]) == tg, bar);
            __builtin_amdgcn_fence(__ATOMIC_ACQUIRE, "agent");
            xb_add(&bar[XB_XGEN(b.x)], 1u);
            asm volatile("s_waitcnt vmcnt(0)" ::: "memory");
        } else {
            XB_SPIN(xb_ld(&bar[XB_XGEN(b.x)]) == gen, bar);
            __builtin_amdgcn_fence(__ATOMIC_ACQUIRE, "agent");
            asm volatile("s_waitcnt vmcnt(0)" ::: "memory");
        }
    }
    __syncthreads();
}


#ifndef MK_MULTI
#define MK_MULTI 0
#endif
constexpr int DM = 1024, NB = 8, SEQ = 2048, MP = NB * SEQ, MS = 128, MR = MP + MS, MPAD = 16640;
constexpr int DFF = 2816, DPLE = 256, DIN = 2048, CONVD = 4096, NH = 32, DST = 128;
constexpr int NIN = 6176, NINP = 6400, NLAYER = 4;
constexpr int PAST = 8192;
constexpr size_t MiB = 1u << 20;
constexpr size_t WS_SS = 0, WS_ROPE = 2 * MiB, WS_GSQ = 3 * MiB, WS_DT = 8 * MiB, WS_KF = 12 * MiB, WS_VT = 20 * MiB, WS_KVRAW = 28 * MiB;
constexpr size_t WS_X = 62 * MiB, WS_XB = 128 * MiB, WS_H = 162 * MiB, WS_PP = 252 * MiB, WS_P16 = 318 * MiB, WS_Z = 352 * MiB, WS_XBC = 418 * MiB, WS_YG = 548 * MiB;
constexpr size_t WS_Q = WS_Z, WS_O = WS_Z + 33 * MiB;
constexpr size_t WS_W = 614 * MiB;
constexpr size_t WL_STRIDE = 36 * MiB, WL_WI1 = 0, WL_WO1 = 11 * MiB, WL_WI2 = 17 * MiB, WL_WO2 = 28 * MiB, WL_WG = 34 * MiB - 512 * 1024, WL_WP = 36 * MiB - 512 * 1024;
constexpr size_t WS_WA = WS_W + 4 * WL_STRIDE, WA_STRIDE = 17 * MiB, WA_WIN = 0, WA_WOUT = 13 * MiB;
constexpr size_t WS_WB = WS_WA + 2 * WA_STRIDE, WB_STRIDE = 4 * MiB, WB_WQ = 0, WB_WO = 2 * MiB;
constexpr size_t WS_WKV = WS_WB + 2 * WB_STRIDE;
constexpr size_t WS_SS2 = WS_WKV + 1 * MiB, WS_XB2 = WS_SS2 + 2 * MiB;
constexpr size_t WS_BAR = WS_XB2 + 33 * MiB, BAR_BYTES = 65536;
constexpr size_t WS_END = WS_BAR + 1 * MiB;
static_assert(WS_END <= 1024 * MiB, "ws");
constexpr size_t O_Y = 0, O_SSMP = 16908288, O_CONVP = 21102592, O_KP = 21299200, O_VP = 21561344, O_SSMS = 21823488, O_CONVS = 88932352, O_KS = 92078080, O_VS = 96272384;
constexpr int LDS_BYTES = 160 * 1024;
constexpr int NPHASE = 1 + 2 * 9 + 2 * 8;

typedef unsigned short bf16;
typedef float f32x4 __attribute__((ext_vector_type(4)));
typedef float f32x16 __attribute__((ext_vector_type(16)));
typedef short bf16x8 __attribute__((ext_vector_type(8)));
typedef unsigned u32x4 __attribute__((ext_vector_type(4)));
typedef unsigned u32x2 __attribute__((ext_vector_type(2)));
using pg8::cvt_pk_bf16;
__device__ __forceinline__ float bflo(unsigned w) { return __uint_as_float(w << 16); }
__device__ __forceinline__ float bfhi(unsigned w) { return __uint_as_float(w & 0xffff0000u); }
__device__ __forceinline__ float bf1(bf16 h) { return __uint_as_float((unsigned)h << 16); }
__device__ __forceinline__ bf16 f2bf(float f) { return (bf16)(cvt_pk_bf16(f, 0.f) & 0xffffu); }
__device__ __forceinline__ float silu_f(float v) { return v * __builtin_amdgcn_rcpf(1.0f + __expf(-v)); }
__device__ __forceinline__ float wave_sum(float v) {
#pragma unroll
    for (int o = 1; o < 64; o <<= 1) v += __shfl_xor(v, o);
    return v;
}
__device__ __forceinline__ float wave_max(float v) {
#pragma unroll
    for (int o = 1; o < 64; o <<= 1) v = fmaxf(v, __shfl_xor(v, o));
    return v;
}
#define LDS_WAIT() asm volatile("s_waitcnt lgkmcnt(0)" ::: "memory")

struct Args { const float* in[33]; float* out; unsigned char* ws; int ph_lo, ph_hi; };
enum { I_XP = 0, I_XS, I_SSM, I_CONV, I_CK, I_CV, I_PP, I_PS, I_F1N, I_F1WI, I_F1WO, I_MIXN, I_F2N, I_F2WI, I_F2WO, I_PLEN, I_PLEG, I_PLEP,
       I_SIN, I_SCW, I_SCB, I_SDTB, I_SALOG, I_SD, I_SNORM, I_SOUT, I_KVN, I_WKV, I_KN, I_WQ, I_QN, I_SINK, I_WO };

__device__ __forceinline__ void p0_transpose_item(const float* W, int K, int N, bf16* WT, const float* gain, int mode, LAS float* scr, int item, int lane) {
    const int nblk = N / 32, kb = item / nblk, nb = item % nblk, k0 = 64 * kb, n0 = 32 * nb;
    int drow0 = n0;
    if (mode == 1) { if (n0 < DFF) drow0 = 256 * (n0 / 128) + (n0 % 128); else { const int j = n0 - DFF; drow0 = 256 * (j / 128) + 128 + (j % 128); } }
    float v[32];
    const float* wp = W + (size_t)(k0 + (lane >> 5)) * N + n0 + (lane & 31);
#pragma unroll
    for (int i = 0; i < 32; ++i) v[i] = wp[(size_t)(2 * i) * N];
    if (gain) {
        const float gv = gain[k0 + lane];
#pragma unroll
        for (int i = 0; i < 32; ++i) { const float g0 = __builtin_bit_cast(float, __builtin_amdgcn_readlane(__builtin_bit_cast(int, gv), 2 * i)), g1 = __builtin_bit_cast(float, __builtin_amdgcn_readlane(__builtin_bit_cast(int, gv), 2 * i + 1));
            v[i] *= (lane >> 5) ? g1 : g0; }
    }
#pragma unroll
    for (int i = 0; i < 32; ++i) scr[(2 * i + (lane >> 5)) * 33 + (lane & 31)] = v[i];
    LDS_WAIT(); asm volatile("" ::: "memory");
    const int c = lane & 7;
#pragma unroll
    for (int j = 0; j < 4; ++j) { const int n = (lane >> 3) + 8 * j; const LAS float* s = scr + (8 * c) * 33 + n;
        u32x4 o; o.x = cvt_pk_bf16(s[0 * 33], s[1 * 33]); o.y = cvt_pk_bf16(s[2 * 33], s[3 * 33]); o.z = cvt_pk_bf16(s[4 * 33], s[5 * 33]); o.w = cvt_pk_bf16(s[6 * 33], s[7 * 33]);
        *(u32x4*)(WT + (size_t)(drow0 + n) * K + k0 + 8 * c) = o; }
    LDS_WAIT(); asm volatile("" ::: "memory");
}
__constant__ double ROPE_T8[8] = {1.0, 0.7498942093324559, 0.5623413251903491, 0.4216965034285822, 0.31622776601683794, 0.23713737056616552, 0.1778279410038923, 0.1333521432163324};
__constant__ double ROPE_P10[4] = {1.0, 0.1, 0.01, 0.001};

__device__ __forceinline__ void p0_prologue(const Args& A, LAS unsigned char* lds, int tid, int lane, int wave) {
    unsigned char* ws = A.ws;
    LAS float* scr = (LAS float*)(lds + wave * 16384);
    const int gw = blockIdx.x * 8 + wave, NGW = gridDim.x * 8;
    const int gt = blockIdx.x * 512 + tid, NGT = gridDim.x * 512;
    for (int job = 0; job < 33; ++job) {
        const float* src; bf16* dst; const float* gain = nullptr; int K, N, mode = 0;
        if (job < 24) { const int L = job / 6, k = job % 6; unsigned char* wl = ws + WS_W + (size_t)L * WL_STRIDE;
            if (k == 0)      { src = A.in[I_F1WI] + (size_t)L * DM * 2 * DFF; dst = (bf16*)(wl + WL_WI1); gain = A.in[I_F1N] + L * DM; K = DM; N = 2 * DFF; mode = 1; }
            else if (k == 1) { src = A.in[I_F1WO] + (size_t)L * DFF * DM;     dst = (bf16*)(wl + WL_WO1); K = DFF; N = DM; }
            else if (k == 2) { src = A.in[I_F2WI] + (size_t)L * DM * 2 * DFF; dst = (bf16*)(wl + WL_WI2); gain = A.in[I_F2N] + L * DM; K = DM; N = 2 * DFF; mode = 1; }
            else if (k == 3) { src = A.in[I_F2WO] + (size_t)L * DFF * DM;     dst = (bf16*)(wl + WL_WO2); K = DFF; N = DM; }
            else if (k == 4) { src = A.in[I_PLEG] + (size_t)L * DM * DM;      dst = (bf16*)(wl + WL_WG); gain = A.in[I_PLEN] + L * DM; K = DM; N = DM; }
            else             { src = A.in[I_PLEP] + (size_t)L * DPLE * DM;    dst = (bf16*)(wl + WL_WP); K = DPLE; N = DM; }
        } else if (job < 28) { const int a = (job - 24) / 2, k = (job - 24) % 2; unsigned char* wl = ws + WS_WA + (size_t)a * WA_STRIDE;
            if (k == 0) { src = A.in[I_SIN] + (size_t)a * DM * NIN;  dst = (bf16*)(wl + WA_WIN); gain = A.in[I_MIXN] + a * DM; K = DM; N = NIN; }
            else        { src = A.in[I_SOUT] + (size_t)a * DIN * DM; dst = (bf16*)(wl + WA_WOUT); gain = A.in[I_SNORM] + a * DIN; K = DIN; N = DM; }
        } else if (job < 32) { const int bb = (job - 28) / 2, k = (job - 28) % 2; unsigned char* wl = ws + WS_WB + (size_t)bb * WB_STRIDE;
            if (k == 0) { src = A.in[I_WQ] + (size_t)bb * DM * DM; dst = (bf16*)(wl + WB_WQ); gain = A.in[I_MIXN] + (2 + bb) * DM; K = DM; N = DM; }
            else        { src = A.in[I_WO] + (size_t)bb * DM * DM; dst = (bf16*)(wl + WB_WO); K = DM; N = DM; }
        } else { src = A.in[I_WKV]; dst = (bf16*)(ws + WS_WKV); gain = A.in[I_KVN]; K = DM; N = 512; }
        const int nitems = (K / 64) * (N / 32);
        for (int it = gw; it < nitems; it += NGW) p0_transpose_item(src, K, N, dst, gain, mode, scr, it, lane);
    }
    for (int i = gt; i < 2 * (NINP - NIN) * DM / 8; i += NGT) { const int a = i / ((NINP - NIN) * DM / 8), r = i % ((NINP - NIN) * DM / 8);
        *(u32x4*)((bf16*)(ws + WS_WA + (size_t)a * WA_STRIDE + WA_WIN) + (size_t)NIN * DM + (size_t)r * 8) = (u32x4){0u, 0u, 0u, 0u}; }
    bf16* XB = (bf16*)(ws + WS_XB); float* SS = (float*)(ws + WS_SS);
    for (int m = gw; m < MPAD; m += NGW) {
        f32x4 v[4]; float s = 0.f;
        if (m < MR) { const float* xr = (m < MP) ? A.in[I_XP] + (size_t)m * DM : A.in[I_XS] + (size_t)(m - MP) * DM;
#pragma unroll
            for (int j = 0; j < 4; ++j) { v[j] = ((const f32x4*)xr)[lane + 64 * j]; s += (v[j][0] * v[j][0] + v[j][1] * v[j][1]) + (v[j][2] * v[j][2] + v[j][3] * v[j][3]); }
        } else {
#pragma unroll
            for (int j = 0; j < 4; ++j) v[j] = (f32x4){0.f, 0.f, 0.f, 0.f};
        }
        s = wave_sum(s);
#pragma unroll
        for (int j = 0; j < 4; ++j) {
            u32x2 w; w.x = cvt_pk_bf16(v[j][0], v[j][1]); w.y = cvt_pk_bf16(v[j][2], v[j][3]); ((u32x2*)(XB + (size_t)m * DM))[lane + 64 * j] = w; }
        if (lane < 16) SS[(size_t)m * 16 + lane] = (lane == 0) ? s : 0.f;
    }
    bf16* P16 = (bf16*)(ws + WS_P16);
    for (int r4 = gw; r4 < NLAYER * MPAD / 4; r4 += NGW) {
        f32x4 v[4];
#pragma unroll
        for (int q = 0; q < 4; ++q) { const int r = r4 * 4 + q, L = r / MPAD, m = r % MPAD; v[q] = (f32x4){0.f, 0.f, 0.f, 0.f};
            if (m < MP) v[q] = ((const f32x4*)(A.in[I_PP] + ((size_t)L * MP + m) * DPLE))[lane]; else if (m < MR) v[q] = ((const f32x4*)(A.in[I_PS] + ((size_t)L * MS + (m - MP)) * DPLE))[lane]; }
#pragma unroll
        for (int q = 0; q < 4; ++q) { u32x2 w; w.x = cvt_pk_bf16(v[q][0], v[q][1]); w.y = cvt_pk_bf16(v[q][2], v[q][3]); ((u32x2*)(P16 + (size_t)(r4 * 4 + q) * DPLE))[lane] = w; }
    }
    float* RT = (float*)(ws + WS_ROPE);
    for (int i = gt; i < 2049 * 32; i += NGT) { const int idx = i >> 5, fi = i & 31; const int pos = idx < SEQ ? idx : PAST;
        const float inv = (float)(ROPE_T8[fi & 7] * ROPE_P10[fi >> 3]); const float ang = (float)pos * inv;
        const double t = (double)ang * 0.15915494309189535; const float fr = (float)(t - rint(t));
        RT[2 * i] = __builtin_amdgcn_cosf(fr); RT[2 * i + 1] = __builtin_amdgcn_sinf(fr); }
    for (int i = gt; i < MS * 127 * 64; i += NGT) { const int b = i / (127 * 64), r = i % (127 * 64);
        ((f32x4*)(A.out + O_KS + (size_t)b * 128 * 256))[r] = ((const f32x4*)(A.in[I_CK] + (size_t)b * 128 * 256 + 256))[r];
        ((f32x4*)(A.out + O_VS + (size_t)b * 128 * 256))[r] = ((const f32x4*)(A.in[I_CV] + (size_t)b * 128 * 256 + 256))[r]; }
}

constexpr int SRS = 272;
constexpr int L_C = 0, L_B = 128 * SRS, L_BW = 2 * 128 * SRS, L_XT = 3 * 128 * SRS, L_HS = L_XT + 64 * SRS, L_CUM = L_HS + 64 * SRS, L_DTV = L_CUM + 512, L_SSD_END = L_DTV + 512;
static_assert(L_SSD_END <= LDS_BYTES, "ssd lds");
__device__ __forceinline__ float softplus_f(float x) { return x > 20.f ? x : log1pf(__expf(x)); }
__device__ __forceinline__ f32x16 mfma32(bf16x8 a, bf16x8 b, f32x16 c) { return __builtin_amdgcn_mfma_f32_32x32x16_bf16(a, b, c, 0, 0, 0); }
__device__ __forceinline__ void unpack8(u32x4 w, float (&f)[8]) { f[0] = bflo(w.x); f[1] = bfhi(w.x); f[2] = bflo(w.y); f[3] = bfhi(w.y); f[4] = bflo(w.z); f[5] = bfhi(w.z); f[6] = bflo(w.w); f[7] = bfhi(w.w); }

__device__ __forceinline__ void ssd_prompt_unit(const Args& A, LAS unsigned char* lds, int layer, int b, int h, int tid, int lane, int wid) {
    unsigned char* ws = A.ws;
    const bf16* XBC = (const bf16*)(ws + WS_XBC); const bf16* Z = (const bf16*)(ws + WS_Z); bf16* YG = (bf16*)(ws + WS_YG); const bf16* BCA = (const bf16*)(ws + WS_H);
    const float* DT = (const float*)(ws + WS_DT); float* GSQ = (float*)(ws + WS_GSQ);
    const int hi = lane >> 5, l32 = lane & 31, g = h >> 2;
    const float a_h = -__expf(A.in[I_SALOG][layer * NH + h]), dtb = A.in[I_SDTB][layer * NH + h], Dh = A.in[I_SD][layer * NH + h];
    LAS float* cum_s = (LAS float*)(lds + L_CUM); LAS float* dt_s = (LAS float*)(lds + L_DTV);
    f32x16 hacc;
#pragma unroll
    for (int r = 0; r < 16; ++r) hacc[r] = 0.f;
    for (int i = tid; i < 64 * SRS / 16; i += 512) *(LAS u32x4*)(lds + L_HS + i * 16) = (u32x4){0u, 0u, 0u, 0u};
    __syncthreads();
    float dtn = 0.f, dtn0 = 0.f;
    if (wid < 2) { dtn = DT[(size_t)(b * SEQ + tid) * 32 + h]; dtn0 = DT[(size_t)(b * SEQ + lane) * 32 + h]; }
    for (int c = 0; c < 16; ++c) {
        const int row0 = b * SEQ + c * 128;
        if (wid < 2) {
            const float dtv = softplus_f(dtn + dtb); float v = dtv * a_h;
#pragma unroll
            for (int o = 1; o < 64; o <<= 1) { const float t = __shfl_up(v, o); if (lane >= o) v += t; }
            if (wid == 1) { const float d0 = softplus_f(dtn0 + dtb) * a_h; v += wave_sum(d0); }
            cum_s[tid] = v; dt_s[tid] = dtv;
            if (c < 15) { dtn = DT[(size_t)(row0 + 128 + tid) * 32 + h]; dtn0 = DT[(size_t)(row0 + 128 + lane) * 32 + h]; }
        }
        __syncthreads();
        if (wid < 4) {
            const int oct = tid & 7, seg = tid >> 3, l0 = seg * 4, t0 = c * 128 + l0, chx = h * 64 + oct * 8;
            float cw[4][8], cb[8];
            {
                const float* cwp = A.in[I_SCW] + (size_t)layer * 4 * CONVD + chx; const float* cbp = A.in[I_SCB] + (size_t)layer * CONVD + chx;
#pragma unroll
                for (int k = 0; k < 4; ++k) { const f32x4 w0 = *(const f32x4*)(cwp + k * CONVD), w1 = *(const f32x4*)(cwp + k * CONVD + 4);
#pragma unroll
                    for (int e = 0; e < 4; ++e) { cw[k][e] = w0[e]; cw[k][4 + e] = w1[e]; } }
                const f32x4 b0 = *(const f32x4*)cbp, b1 = *(const f32x4*)(cbp + 4);
#pragma unroll
                for (int e = 0; e < 4; ++e) { cb[e] = b0[e]; cb[4 + e] = b1[e]; }
            }
            const bf16* src = XBC + (size_t)(b * SEQ + t0) * CONVD + chx;
            u32x4 rw[7];
#pragma unroll
            for (int j = 0; j < 7; ++j) { if (j < 3 && t0 < 3) rw[j] = (u32x4){0u, 0u, 0u, 0u}; else rw[j] = *(const u32x4*)(src + (j - 3) * CONVD); }
            float r0[8], r1[8], r2[8]; unpack8(rw[0], r0); unpack8(rw[1], r1); unpack8(rw[2], r2);
            unsigned tp[8][2];
#pragma unroll
            for (int i2 = 0; i2 < 2; ++i2) {
                float na[8], nb2[8]; unpack8(rw[3 + 2 * i2], na); unpack8(rw[4 + 2 * i2], nb2);
#pragma unroll
                for (int e = 0; e < 8; ++e) {
                    const float va = cb[e] + cw[0][e] * r0[e] + cw[1][e] * r1[e] + cw[2][e] * r2[e] + cw[3][e] * na[e];
                    const float vb = cb[e] + cw[0][e] * r1[e] + cw[1][e] * r2[e] + cw[2][e] * na[e] + cw[3][e] * nb2[e];
                    tp[e][i2] = cvt_pk_bf16(silu_f(va), silu_f(vb));
                    r0[e] = r2[e]; r1[e] = na[e]; r2[e] = nb2[e];
                }
            }
#pragma unroll
            for (int e = 0; e < 8; ++e) *(LAS u32x2*)(lds + L_XT + (oct * 8 + e) * SRS + l0 * 2) = (u32x2){tp[e][0], tp[e][1]};
        } else if (wid < 6) {
            const int t = tid - 256, oct = t & 15, l0 = (t >> 4) * 16; const float cl = cum_s[127];
            const bf16* src = BCA + (size_t)(row0 + l0) * 2048 + g * 128 + oct * 8;
#pragma unroll 2
            for (int hf = 0; hf < 4; ++hf) {
                u32x4 rw[4]; float f[4][8], sc[4];
#pragma unroll
                for (int j = 0; j < 4; ++j) rw[j] = *(const u32x4*)(src + (size_t)(4 * hf + j) * 2048);
#pragma unroll
                for (int j = 0; j < 4; ++j) { const int l = l0 + 4 * hf + j; *(LAS u32x4*)(lds + L_B + l * SRS + oct * 16) = rw[j]; unpack8(rw[j], f[j]); sc[j] = dt_s[l] * __expf(cl - cum_s[l]); }
#pragma unroll
                for (int e = 0; e < 8; ++e) *(LAS u32x2*)(lds + L_BW + (oct * 8 + e) * SRS + (l0 + 4 * hf) * 2) = (u32x2){cvt_pk_bf16(f[0][e] * sc[0], f[1][e] * sc[1]), cvt_pk_bf16(f[2][e] * sc[2], f[3][e] * sc[3])};
            }
        } else {
            const int t = tid - 384, oct = t & 15, l0 = (t >> 4) * 16;
            const bf16* src = BCA + (size_t)(row0 + l0) * 2048 + 1024 + g * 128 + oct * 8;
#pragma unroll 8
            for (int j = 0; j < 16; ++j) *(LAS u32x4*)(lds + L_C + (l0 + j) * SRS + oct * 16) = *(const u32x4*)(src + (size_t)j * 2048);
        }
        __syncthreads();
        u32x2 zpre[4];
        {
            const int pb = wid & 1, lb = wid >> 1; const size_t zrow = (size_t)row0 + 32 * lb + l32;
#pragma unroll
            for (int rq = 0; rq < 4; ++rq) zpre[rq] = *(const u32x2*)(Z + zrow * DIN + h * 64 + 32 * pb + 8 * rq + 4 * hi);
        }
        {
            const int lb = wid >> 1;
            f32x16 cacc[2];
#pragma unroll
            for (int t = 0; t < 2; ++t) {
#pragma unroll
                for (int r = 0; r < 16; ++r) cacc[t][r] = 0.f;
                const int sb = 2 * (wid & 1) + t;
                if (sb <= lb) {
#pragma unroll
                    for (int ks = 0; ks < 8; ++ks) {
                        const bf16x8 av = *(const LAS bf16x8*)(lds + L_B + (32 * sb + l32) * SRS + (16 * ks + 8 * hi) * 2);
                        const bf16x8 bv = *(const LAS bf16x8*)(lds + L_C + (32 * lb + l32) * SRS + (16 * ks + 8 * hi) * 2);
                        cacc[t] = mfma32(av, bv, cacc[t]);
                    }
                }
            }
            __syncthreads();
            const int l = 32 * lb + l32; const float cll = cum_s[l];
#pragma unroll
            for (int t = 0; t < 2; ++t) {
                const int sb = 2 * (wid & 1) + t;
                if (sb <= lb) {
#pragma unroll
                    for (int rq = 0; rq < 4; ++rq) {
                        const int s0 = 32 * sb + 8 * rq + 4 * hi; float v[4];
#pragma unroll
                        for (int e = 0; e < 4; ++e) { const int s = s0 + e; float x = cacc[t][4 * rq + e] * __expf(cll - cum_s[s]) * dt_s[s]; x = (s > l) ? 0.f : x; x = (s == l) ? x + Dh : x; v[e] = x; }
                        u32x2 w; w.x = cvt_pk_bf16(v[0], v[1]); w.y = cvt_pk_bf16(v[2], v[3]);
                        *(LAS u32x2*)(lds + L_B + l * SRS + s0 * 2) = w;
                    }
                }
            }
        }
        __syncthreads();
        {
            const int pb = wid & 1, lb = wid >> 1;
            f32x16 yacc;
#pragma unroll
            for (int r = 0; r < 16; ++r) yacc[r] = 0.f;
#pragma unroll
            for (int ks = 0; ks < 8; ++ks) {
                const bf16x8 av = *(const LAS bf16x8*)(lds + L_HS + (32 * pb + l32) * SRS + (16 * ks + 8 * hi) * 2);
                const bf16x8 bv = *(const LAS bf16x8*)(lds + L_C + (32 * lb + l32) * SRS + (16 * ks + 8 * hi) * 2);
                yacc = mfma32(av, bv, yacc);
            }
            const float el = __expf(cum_s[32 * lb + l32]);
#pragma unroll
            for (int r = 0; r < 16; ++r) yacc[r] *= el;
            for (int sb = 0; sb <= lb; ++sb) {
#pragma unroll
                for (int k2 = 0; k2 < 2; ++k2) {
                    const bf16x8 av = *(const LAS bf16x8*)(lds + L_XT + (32 * pb + l32) * SRS + (32 * sb + 16 * k2 + 8 * hi) * 2);
                    const bf16x8 bv = *(const LAS bf16x8*)(lds + L_B + (32 * lb + l32) * SRS + (32 * sb + 16 * k2 + 8 * hi) * 2);
                    yacc = mfma32(av, bv, yacc);
                }
            }
            const size_t row = (size_t)row0 + 32 * lb + l32; float sq = 0.f;
#pragma unroll
            for (int rq = 0; rq < 4; ++rq) {
                const int p0 = 32 * pb + 8 * rq + 4 * hi; const u32x2 zz = zpre[rq];
                const float g0 = yacc[4 * rq + 0] * silu_f(bflo(zz.x)), g1 = yacc[4 * rq + 1] * silu_f(bfhi(zz.x)), g2 = yacc[4 * rq + 2] * silu_f(bflo(zz.y)), g3 = yacc[4 * rq + 3] * silu_f(bfhi(zz.y));
                sq += (g0 * g0 + g1 * g1) + (g2 * g2 + g3 * g3);
                u32x2 w; w.x = cvt_pk_bf16(g0, g1); w.y = cvt_pk_bf16(g2, g3); *(u32x2*)(YG + row * DIN + h * 64 + p0) = w;
            }
            sq += __shfl_xor(sq, 32);
            if (hi == 0) __hip_atomic_store(GSQ + row * 64 + 2 * h + pb, sq, __ATOMIC_RELAXED, __HIP_MEMORY_SCOPE_AGENT);
        }
        const int nb = wid & 3, pb2 = wid >> 2;
        {
            const float dl = __expf(cum_s[127]);
#pragma unroll
            for (int r = 0; r < 16; ++r) hacc[r] *= dl;
#pragma unroll
            for (int ks = 0; ks < 8; ++ks) {
                const bf16x8 av = *(const LAS bf16x8*)(lds + L_BW + (32 * nb + l32) * SRS + (16 * ks + 8 * hi) * 2);
                const bf16x8 bv = *(const LAS bf16x8*)(lds + L_XT + (32 * pb2 + l32) * SRS + (16 * ks + 8 * hi) * 2);
                hacc = mfma32(av, bv, hacc);
            }
        }
        __syncthreads();
        {
            const int p = 32 * pb2 + l32;
#pragma unroll
            for (int rq = 0; rq < 4; ++rq) { const int n0 = 32 * nb + 8 * rq + 4 * hi; u32x2 w; w.x = cvt_pk_bf16(hacc[4 * rq], hacc[4 * rq + 1]); w.y = cvt_pk_bf16(hacc[4 * rq + 2], hacc[4 * rq + 3]);
                *(LAS u32x2*)(lds + L_HS + p * SRS + n0 * 2) = w; }
        }
    }
    int lane2 = lane; asm volatile("" : "+v"(lane2));
    {
        const int hi = lane2 >> 5, l32 = lane2 & 31;
        const int nb = wid & 3, pb2 = wid >> 2, p = 32 * pb2 + l32;
        float* o = A.out + O_SSMP + (((size_t)(layer * NB + b) * NH + h) * 64 + p) * DST;
#pragma unroll
        for (int rq = 0; rq < 4; ++rq) { const int n0 = 32 * nb + 8 * rq + 4 * hi; *(f32x4*)(o + n0) = (f32x4){hacc[4 * rq], hacc[4 * rq + 1], hacc[4 * rq + 2], hacc[4 * rq + 3]}; }
    }
    const int tid2 = wid * 64 + lane2;
    {
        asm volatile("s_waitcnt vmcnt(0)" ::: "memory"); __syncthreads();
        unsigned* cnt = (unsigned*)(ws + WS_BAR + 32768) + (size_t)((layer * NB + b) * 8 + g) * 64;
        if (wid == 0) {
            if (lane2 == 0) { (void)__hip_atomic_fetch_add(cnt, 1u, __ATOMIC_RELAXED, __HIP_MEMORY_SCOPE_AGENT);
                unsigned sp = 0; while (__hip_atomic_load(cnt, __ATOMIC_RELAXED, __HIP_MEMORY_SCOPE_AGENT) < 4u) { __builtin_amdgcn_s_sleep(2); if (++sp > (1u << 22)) break; } }
            __builtin_amdgcn_fence(__ATOMIC_ACQUIRE, "agent"); asm volatile("s_waitcnt vmcnt(0)" ::: "memory");
        }
        __syncthreads();
        const int oct = tid2 & 7, r0n = tid2 >> 3;
#pragma unroll 4
        for (int j = 0; j < 32; ++j) { const size_t row = (size_t)b * SEQ + r0n + 64 * j;
            const f32x4 s0 = *(const f32x4*)(GSQ + row * 64 + g * 8), s1 = *(const f32x4*)(GSQ + row * 64 + g * 8 + 4);
            const float rs = __builtin_amdgcn_rsqf((((s0[0] + s0[1]) + (s0[2] + s0[3])) + ((s1[0] + s1[1]) + (s1[2] + s1[3]))) * (1.0f / 256.0f) + 1e-6f);
            u32x4* pp = (u32x4*)(YG + row * DIN + h * 64 + oct * 8); const u32x4 w = *pp; float f[8]; unpack8(w, f);
            u32x4 o; o.x = cvt_pk_bf16(f[0] * rs, f[1] * rs); o.y = cvt_pk_bf16(f[2] * rs, f[3] * rs); o.z = cvt_pk_bf16(f[4] * rs, f[5] * rs); o.w = cvt_pk_bf16(f[6] * rs, f[7] * rs); *pp = o; }
    }
    if (tid2 < 384) { const int k = tid2 >> 7, j = tid2 & 127, chn = h * 128 + j;
        A.out[O_CONVP + ((size_t)(layer * NB + b) * 3 + k) * CONVD + chn] = bf1(XBC[(size_t)(b * SEQ + SEQ - 3 + k) * CONVD + chn]); }
    __syncthreads();
}

__device__ __forceinline__ void ssd_sample_item(const Args& A, int layer, int b, int h, int lane) {
    unsigned char* ws = A.ws;
    const bf16* XBC = (const bf16*)(ws + WS_XBC); const bf16* Z = (const bf16*)(ws + WS_Z); bf16* YG = (bf16*)(ws + WS_YG);
    const float* DT = (const float*)(ws + WS_DT); float* GSQ = (float*)(ws + WS_GSQ);
    const int g = h >> 2, psub = lane >> 4, nch = lane & 15, n0 = 8 * nch; const size_t row = (size_t)MP + b;
    const float* cwp = A.in[I_SCW] + (size_t)layer * 4 * CONVD; const float* cbp = A.in[I_SCB] + (size_t)layer * CONVD;
    const float* c0 = A.in[I_CONV] + ((size_t)layer * MS + b) * 3 * CONVD;
    float Bv[8], Cv[8];
    {
        const int chB = DIN + g * 128 + n0, chC = DIN + 1024 + g * 128 + n0;
        float nB[8], nC[8]; unpack8(*(const u32x4*)(XBC + row * CONVD + chB), nB); unpack8(*(const u32x4*)(XBC + row * CONVD + chC), nC);
#pragma unroll
        for (int e = 0; e < 8; ++e) {
            float vb = cbp[chB + e] + cwp[3 * CONVD + chB + e] * nB[e], vc = cbp[chC + e] + cwp[3 * CONVD + chC + e] * nC[e];
#pragma unroll
            for (int k = 0; k < 3; ++k) { vb += cwp[k * CONVD + chB + e] * c0[k * CONVD + chB + e]; vc += cwp[k * CONVD + chC + e] * c0[k * CONVD + chC + e]; }
            Bv[e] = silu_f(vb); Cv[e] = silu_f(vc);
        }
    }
    float xact;
    { const int chx = h * 64 + lane; float v = cbp[chx] + cwp[3 * CONVD + chx] * bf1(XBC[row * CONVD + chx]);
#pragma unroll
      for (int k = 0; k < 3; ++k) v += cwp[k * CONVD + chx] * c0[k * CONVD + chx];
      xact = silu_f(v); }
    const float a_h = -__expf(A.in[I_SALOG][layer * NH + h]), Dh = A.in[I_SD][layer * NH + h];
    const float dtv = softplus_f(DT[row * 32 + h] + A.in[I_SDTB][layer * NH + h]); const float dec = __expf(dtv * a_h);
    const float* h0 = A.in[I_SSM] + (((size_t)layer * MS + b) * NH + h) * 64 * DST; float* h1 = A.out + O_SSMS + (((size_t)layer * MS + b) * NH + h) * 64 * DST;
    float sq = 0.f;
#pragma unroll 4
    for (int it = 0; it < 16; ++it) {
        const int p = 4 * it + psub; const float xp = __shfl(xact, p); const float xd = xp * dtv;
        const f32x4 a0 = *(const f32x4*)(h0 + p * DST + n0), a1 = *(const f32x4*)(h0 + p * DST + n0 + 4);
        f32x4 o0, o1; float yp = 0.f;
#pragma unroll
        for (int e = 0; e < 4; ++e) { o0[e] = dec * a0[e] + xd * Bv[e]; o1[e] = dec * a1[e] + xd * Bv[4 + e]; yp += o0[e] * Cv[e] + o1[e] * Cv[4 + e]; }
        *(f32x4*)(h1 + p * DST + n0) = o0; *(f32x4*)(h1 + p * DST + n0 + 4) = o1;
        yp += __shfl_xor(yp, 1); yp += __shfl_xor(yp, 2); yp += __shfl_xor(yp, 4); yp += __shfl_xor(yp, 8);
        if (nch == 0) { const float y = yp + Dh * xp; const float gt = y * silu_f(bf1(Z[row * DIN + h * 64 + p])); sq += gt * gt; YG[row * DIN + h * 64 + p] = f2bf(gt); }
    }
    sq += __shfl_xor(sq, 16); sq += __shfl_xor(sq, 32);
    if (lane == 0) { GSQ[row * 64 + 2 * h] = sq; GSQ[row * 64 + 2 * h + 1] = 0.f; }
}

__device__ __forceinline__ void ssd_pre_phase(const Args& A, int layer, int tid, int lane, int wid) {
    const bf16* XBC = (const bf16*)(A.ws + WS_XBC); bf16* BCA = (bf16*)(A.ws + WS_H);
    for (int task = blockIdx.x * 512 + tid; task < 256 * (MP / 32); task += gridDim.x * 512) {
        const int oct = task & 255, m0 = (task >> 8) * 32, t0 = m0 % SEQ, chn = DIN + oct * 8;
        float cw[4][8], cb[8];
        {
            const float* cwp = A.in[I_SCW] + (size_t)layer * 4 * CONVD + chn; const float* cbp = A.in[I_SCB] + (size_t)layer * CONVD + chn;
#pragma unroll
            for (int k = 0; k < 4; ++k) { const f32x4 w0 = *(const f32x4*)(cwp + k * CONVD), w1 = *(const f32x4*)(cwp + k * CONVD + 4);
#pragma unroll
                for (int e = 0; e < 4; ++e) { cw[k][e] = w0[e]; cw[k][4 + e] = w1[e]; } }
            const f32x4 b0 = *(const f32x4*)cbp, b1 = *(const f32x4*)(cbp + 4);
#pragma unroll
            for (int e = 0; e < 4; ++e) { cb[e] = b0[e]; cb[4 + e] = b1[e]; }
        }
        const bf16* src = XBC + (size_t)m0 * CONVD + chn; bf16* dst = BCA + (size_t)m0 * 2048 + oct * 8;
        float r0[8], r1[8], r2[8];
        if (t0 >= 3) { unpack8(*(const u32x4*)(src - 3 * CONVD), r0); unpack8(*(const u32x4*)(src - 2 * CONVD), r1); unpack8(*(const u32x4*)(src - 1 * CONVD), r2); }
        else {
#pragma unroll
            for (int e = 0; e < 8; ++e) { r0[e] = 0.f; r1[e] = 0.f; r2[e] = 0.f; }
        }
#pragma unroll 1
        for (int i8 = 0; i8 < 4; ++i8) {
            u32x4 rw[8];
#pragma unroll
            for (int j = 0; j < 8; ++j) rw[j] = *(const u32x4*)(src + (size_t)(8 * i8 + j) * CONVD);
#pragma unroll
            for (int j = 0; j < 8; ++j) {
                float na[8], aa[8]; unpack8(rw[j], na);
#pragma unroll
                for (int e = 0; e < 8; ++e) { aa[e] = silu_f(cb[e] + cw[0][e] * r0[e] + cw[1][e] * r1[e] + cw[2][e] * r2[e] + cw[3][e] * na[e]); r0[e] = r1[e]; r1[e] = r2[e]; r2[e] = na[e]; }
                u32x4 w; w.x = cvt_pk_bf16(aa[0], aa[1]); w.y = cvt_pk_bf16(aa[2], aa[3]); w.z = cvt_pk_bf16(aa[4], aa[5]); w.w = cvt_pk_bf16(aa[6], aa[7]);
                *(u32x4*)(dst + (size_t)(8 * i8 + j) * 2048) = w;
            }
        }
    }
    for (int it = blockIdx.x * 8 + wid; it < MS * NH; it += gridDim.x * 8) {
        const int bs = it / NH, hs = it % NH; ssd_sample_item(A, layer, bs, hs, lane);
        __syncthreads();
        { const float* GSQ = (const float*)(A.ws + WS_GSQ); bf16* YG = (bf16*)(A.ws + WS_YG); const size_t row = (size_t)MP + bs; const int gs = hs >> 2;
          const f32x4 s0 = *(const f32x4*)(GSQ + row * 64 + gs * 8), s1 = *(const f32x4*)(GSQ + row * 64 + gs * 8 + 4);
          const float rs = __builtin_amdgcn_rsqf((((s0[0] + s0[1]) + (s0[2] + s0[3])) + ((s1[0] + s1[1]) + (s1[2] + s1[3]))) * (1.0f / 256.0f) + 1e-6f);
          bf16* yp = YG + row * DIN + hs * 64 + lane; *yp = f2bf(bf1(*yp) * rs); }
    }
    for (int i = blockIdx.x * 512 + tid; i < MS * 3 * CONVD; i += gridDim.x * 512) { const int b = i / (3 * CONVD), r = i % (3 * CONVD), k = r / CONVD, chn = r % CONVD;
        A.out[O_CONVS + (size_t)layer * MS * 3 * CONVD + i] = (k < 2) ? A.in[I_CONV][((size_t)layer * MS + b) * 3 * CONVD + (k + 1) * CONVD + chn] : bf1(XBC[(size_t)(MP + b) * CONVD + chn]); }
}
__device__ __forceinline__ void ssd_phase(const Args& A, LAS unsigned char* lds, int layer, int tid, int lane, int wid) {
    for (int u = blockIdx.x; u < NB * NH; u += gridDim.x) ssd_prompt_unit(A, lds, layer, u / NH, u % NH, tid, lane, wid);
}
__device__ __forceinline__ void gnorm_phase(const Args& A, int tid) {
    bf16* YG = (bf16*)(A.ws + WS_YG); const float* GSQ = (const float*)(A.ws + WS_GSQ);
    for (int i = blockIdx.x * 512 + tid; i < MR * 256; i += gridDim.x * 512) { const int m = i >> 8, c8 = i & 255, g = c8 >> 5;
        const f32x4 s0 = *(const f32x4*)(GSQ + (size_t)m * 64 + g * 8), s1 = *(const f32x4*)(GSQ + (size_t)m * 64 + g * 8 + 4);
        const float s = ((s0[0] + s0[1]) + (s0[2] + s0[3])) + ((s1[0] + s1[1]) + (s1[2] + s1[3])); const float rs = __builtin_amdgcn_rsqf(s * (1.0f / 256.0f) + 1e-6f);
        u32x4* p = (u32x4*)(YG + (size_t)m * DIN + c8 * 8); const u32x4 w = *p; float f[8]; unpack8(w, f);
        u32x4 o; o.x = cvt_pk_bf16(f[0] * rs, f[1] * rs); o.y = cvt_pk_bf16(f[2] * rs, f[3] * rs); o.z = cvt_pk_bf16(f[4] * rs, f[5] * rs); o.w = cvt_pk_bf16(f[6] * rs, f[7] * rs); *p = o; }
}

__device__ __forceinline__ void kv_finalize(const Args& A, int lane, int wid) {
    unsigned char* ws = A.ws; const float* KV = (const float*)(ws + WS_KVRAW); const float* RT = (const float*)(ws + WS_ROPE);
    bf16* KF = (bf16*)(ws + WS_KF); bf16* VT = (bf16*)(ws + WS_VT);
    const int kvh = lane >> 4, j = lane & 15;
    const float gn0 = A.in[I_KN][2 * j], gn1 = A.in[I_KN][2 * j + 1], gn2 = A.in[I_KN][2 * j + 32], gn3 = A.in[I_KN][2 * j + 33];
    for (int m = blockIdx.x * 8 + wid; m < MR; m += gridDim.x * 8) {
        const float* kr = KV + (size_t)m * 512 + kvh * 64; const float* vr = kr + 256;
        float x10 = kr[2 * j], x11 = kr[2 * j + 1], x20 = kr[2 * j + 32], x21 = kr[2 * j + 33];
        float ss = (x10 * x10 + x11 * x11) + (x20 * x20 + x21 * x21);
        ss += __shfl_xor(ss, 1); ss += __shfl_xor(ss, 2); ss += __shfl_xor(ss, 4); ss += __shfl_xor(ss, 8);
        const float rs = __builtin_amdgcn_rsqf(ss * (1.0f / 64.0f) + 1e-6f);
        x10 *= rs * gn0; x11 *= rs * gn1; x20 *= rs * gn2; x21 *= rs * gn3;
        const int pidx = m < MP ? (m % SEQ) : SEQ;
        const f32x4 cs = *(const f32x4*)(RT + ((size_t)pidx * 32 + 2 * j) * 2);
        const float o10 = x10 * cs[0] - x20 * cs[1], o20 = x20 * cs[0] + x10 * cs[1], o11 = x11 * cs[2] - x21 * cs[3], o21 = x21 * cs[2] + x11 * cs[3];
        const f32x4 v4 = *(const f32x4*)(vr + 4 * j);
        if (m < MP) {
            const int b = m / SEQ, t = m % SEQ; const size_t bk = (size_t)b * 4 + kvh;
            bf16* kd = KF + (bk * SEQ + t) * 64;
            *(unsigned*)(kd + 2 * j) = cvt_pk_bf16(o10, o11); *(unsigned*)(kd + 2 * j + 32) = cvt_pk_bf16(o20, o21);
            bf16* vd = VT + ((bk * 64 + (t >> 5)) * 64 + 4 * j) * 32 + (t & 31);
            vd[0] = f2bf(v4[0]); vd[32] = f2bf(v4[1]); vd[64] = f2bf(v4[2]); vd[96] = f2bf(v4[3]);
            if (t >= SEQ - 128) { float* ko = A.out + O_KP + (((size_t)b * 128 + (t - (SEQ - 128))) * 4 + kvh) * 64; float* vo = A.out + O_VP + (((size_t)b * 128 + (t - (SEQ - 128))) * 4 + kvh) * 64;
                ko[2 * j] = o10; ko[2 * j + 1] = o11; ko[2 * j + 32] = o20; ko[2 * j + 33] = o21; *(f32x4*)(vo + 4 * j) = v4; }
        } else {
            const int b = m - MP; float* ko = A.out + O_KS + (((size_t)b * 128 + 127) * 4 + kvh) * 64; float* vo = A.out + O_VS + (((size_t)b * 128 + 127) * 4 + kvh) * 64;
            ko[2 * j] = o10; ko[2 * j + 1] = o11; ko[2 * j + 32] = o20; ko[2 * j + 33] = o21; *(f32x4*)(vo + 4 * j) = v4;
        }
    }
}

constexpr int KRS = 144, VRS = 80, L_AK = 0, L_AV = 256 * KRS;
__device__ __forceinline__ void attn_prompt_tile(const Args& A, LAS unsigned char* lds, int lt0, int jl, int b, int hq, int r0, int lane) {
    unsigned char* ws = A.ws; const bf16* Q = (const bf16*)(ws + WS_Q); bf16* O = (bf16*)(ws + WS_O); const float* RT = (const float*)(ws + WS_ROPE);
    const bf16* KF = (const bf16*)(ws + WS_KF); const bf16* VT = (const bf16*)(ws + WS_VT);
    const int hi = lane >> 5, l32 = lane & 31, kvh = hq >> 2; const size_t bk = (size_t)b * 4 + kvh;
    const int qp = r0 + l32; const size_t qrow = (size_t)b * SEQ + qp;
    bf16x8 qf[4];
    {
        float qv[4][8]; float ss = 0.f;
#pragma unroll
        for (int ks = 0; ks < 4; ++ks) { unpack8(*(const u32x4*)(Q + qrow * DM + hq * 64 + 16 * ks + 8 * hi), qv[ks]);
#pragma unroll
            for (int e = 0; e < 8; ++e) ss += qv[ks][e] * qv[ks][e]; }
        ss += __shfl_xor(ss, 32);
        const float rs = __builtin_amdgcn_rsqf(ss * (1.0f / 64.0f) + 1e-6f) * 0.125f;
        const float* qn = A.in[I_QN] + jl * 64;
#pragma unroll
        for (int ks = 0; ks < 2; ++ks) {
            float o1[8], o2[8];
#pragma unroll
            for (int e = 0; e < 8; ++e) { const int i = 16 * ks + 8 * hi + e; const float x1 = qv[ks][e] * rs * qn[i], x2 = qv[ks + 2][e] * rs * qn[i + 32];
                const float cs = RT[((size_t)qp * 32 + i) * 2], sn = RT[((size_t)qp * 32 + i) * 2 + 1]; o1[e] = x1 * cs - x2 * sn; o2[e] = x2 * cs + x1 * sn; }
            u32x4 w; w.x = cvt_pk_bf16(o1[0], o1[1]); w.y = cvt_pk_bf16(o1[2], o1[3]); w.z = cvt_pk_bf16(o1[4], o1[5]); w.w = cvt_pk_bf16(o1[6], o1[7]); qf[ks] = __builtin_bit_cast(bf16x8, w);
            w.x = cvt_pk_bf16(o2[0], o2[1]); w.y = cvt_pk_bf16(o2[2], o2[3]); w.z = cvt_pk_bf16(o2[4], o2[5]); w.w = cvt_pk_bf16(o2[6], o2[7]); qf[ks + 2] = __builtin_bit_cast(bf16x8, w);
        }
    }
    f32x16 s[5];
    const float NEG = -1e30f;
#pragma unroll
    for (int kt = 0; kt < 5; ++kt) {
        const int k0 = r0 - 128 + 32 * kt;
#pragma unroll
        for (int r = 0; r < 16; ++r) s[kt][r] = 0.f;
        if (k0 >= 0) {
#pragma unroll
            for (int ks = 0; ks < 4; ++ks) { const bf16x8 kf = *(const LAS bf16x8*)(lds + L_AK + (32 * (lt0 + kt) + l32) * KRS + (16 * ks + 8 * hi) * 2); s[kt] = mfma32(kf, qf[ks], s[kt]); }
        }
    }
    const float sink = A.in[I_SINK][jl * 16 + hq];
    float mx = sink;
#pragma unroll
    for (int kt = 0; kt < 5; ++kt) {
        const int k0 = r0 - 128 + 32 * kt;
#pragma unroll
        for (int r = 0; r < 16; ++r) { const int kp = k0 + (r & 3) + 8 * (r >> 2) + 4 * hi; const bool ok = (kp >= 0) && (kp <= qp) && (qp - kp <= 128);
            s[kt][r] = ok ? s[kt][r] : NEG; mx = fmaxf(mx, s[kt][r]); }
    }
    mx = fmaxf(mx, __shfl_xor(mx, 32));
    float sum = 0.f;
#pragma unroll
    for (int kt = 0; kt < 5; ++kt)
#pragma unroll
        for (int r = 0; r < 16; ++r) { const float p = __expf(s[kt][r] - mx); s[kt][r] = p; sum += p; }
    sum += __shfl_xor(sum, 32);
    sum += __expf(sink - mx);
    f32x16 oacc[2];
#pragma unroll
    for (int dt = 0; dt < 2; ++dt)
#pragma unroll
        for (int r = 0; r < 16; ++r) oacc[dt][r] = 0.f;
#pragma unroll
    for (int kt = 0; kt < 5; ++kt) {
        const int k0 = r0 - 128 + 32 * kt;
        if (k0 >= 0) {
#pragma unroll
            for (int k2 = 0; k2 < 2; ++k2) {
                u32x4 pw; pw.x = cvt_pk_bf16(s[kt][8 * k2], s[kt][8 * k2 + 1]); pw.y = cvt_pk_bf16(s[kt][8 * k2 + 2], s[kt][8 * k2 + 3]); pw.z = cvt_pk_bf16(s[kt][8 * k2 + 4], s[kt][8 * k2 + 5]); pw.w = cvt_pk_bf16(s[kt][8 * k2 + 6], s[kt][8 * k2 + 7]);
                const bf16x8 pf = __builtin_bit_cast(bf16x8, pw);
#pragma unroll
                for (int dt = 0; dt < 2; ++dt) {
                    const LAS unsigned char* vp = lds + L_AV + ((lt0 + kt) * 64 + 32 * dt + l32) * VRS + (16 * k2 + 4 * hi) * 2;
                    const u32x2 v0 = *(const LAS u32x2*)vp, v1 = *(const LAS u32x2*)(vp + 16);
                    const bf16x8 vf = __builtin_bit_cast(bf16x8, ((u32x4){v0.x, v0.y, v1.x, v1.y}));
                    oacc[dt] = mfma32(vf, pf, oacc[dt]);
                }
            }
        }
    }
    const float inv = __builtin_amdgcn_rcpf(sum);
#pragma unroll
    for (int dt = 0; dt < 2; ++dt)
#pragma unroll
        for (int rq = 0; rq < 4; ++rq) { const int d0 = 32 * dt + 8 * rq + 4 * hi; u32x2 w; w.x = cvt_pk_bf16(oacc[dt][4 * rq] * inv, oacc[dt][4 * rq + 1] * inv); w.y = cvt_pk_bf16(oacc[dt][4 * rq + 2] * inv, oacc[dt][4 * rq + 3] * inv);
            *(u32x2*)(O + qrow * DM + hq * 64 + d0) = w; }
}
__device__ __forceinline__ void attn_sample_item(const Args& A, int jl, int b, int hq, int lane) {
    unsigned char* ws = A.ws; const bf16* Q = (const bf16*)(ws + WS_Q); bf16* O = (bf16*)(ws + WS_O); const float* RT = (const float*)(ws + WS_ROPE);
    const int kvh = hq >> 2; const size_t row = (size_t)MP + b;
    float qv = bf1(Q[row * DM + hq * 64 + lane]);
    const float ss = wave_sum(qv * qv); qv *= __builtin_amdgcn_rsqf(ss * (1.0f / 64.0f) + 1e-6f) * A.in[I_QN][jl * 64 + lane];
    const float other = __shfl_xor(qv, 32); const int i32 = lane & 31; const float cs = RT[((size_t)SEQ * 32 + i32) * 2], sn = RT[((size_t)SEQ * 32 + i32) * 2 + 1];
    const float qr = ((lane < 32) ? (qv * cs - other * sn) : (qv * cs + other * sn)) * 0.125f;
    const int dq = lane & 15, kg = lane >> 4;
    f32x4 q4;
#pragma unroll
    for (int e = 0; e < 4; ++e) q4[e] = __shfl(qr, 4 * dq + e);
    const float* ck = A.in[I_CK] + (size_t)b * 128 * 256 + kvh * 64 + 4 * dq; const float* kn = A.out + O_KS + ((size_t)b * 128 + 127) * 256 + kvh * 64 + 4 * dq;
    const float* cv = A.in[I_CV] + (size_t)b * 128 * 256 + kvh * 64 + 4 * dq; const float* vn = A.out + O_VS + ((size_t)b * 128 + 127) * 256 + kvh * 64 + 4 * dq;
    float sc[33];
#pragma unroll
    for (int i = 0; i < 33; ++i) { const int j = 4 * i + kg; float a = 0.f;
        if (j <= 128) { const f32x4 k4 = *(const f32x4*)((j < 128) ? ck + (size_t)j * 256 : kn); a = (k4[0] * q4[0] + k4[1] * q4[1]) + (k4[2] * q4[2] + k4[3] * q4[3]); }
        sc[i] = a;
        if (i % 11 == 10) asm volatile("" ::: "memory"); }
    const float sink = A.in[I_SINK][jl * 16 + hq];
    float mx = sink;
#pragma unroll
    for (int i = 0; i < 33; ++i) { float a = sc[i]; a += __shfl_xor(a, 1); a += __shfl_xor(a, 2); a += __shfl_xor(a, 4); a += __shfl_xor(a, 8);
        a = (4 * i + kg <= 128) ? a : -1e30f; sc[i] = a; mx = fmaxf(mx, a); }
    mx = fmaxf(mx, __shfl_xor(mx, 16)); mx = fmaxf(mx, __shfl_xor(mx, 32));
    float sum = 0.f;
#pragma unroll
    for (int i = 0; i < 33; ++i) { const float p = __expf(sc[i] - mx); sc[i] = p; sum += p; }
    sum += __shfl_xor(sum, 16); sum += __shfl_xor(sum, 32);
    sum += __expf(sink - mx);
    f32x4 o4 = (f32x4){0.f, 0.f, 0.f, 0.f};
#pragma unroll
    for (int i = 0; i < 33; ++i) { const int j = 4 * i + kg;
        if (j <= 128) { const f32x4 v4 = *(const f32x4*)((j < 128) ? cv + (size_t)j * 256 : vn); o4 += v4 * sc[i]; }
        if (i % 11 == 10) asm volatile("" ::: "memory"); }
#pragma unroll
    for (int e = 0; e < 4; ++e) { o4[e] += __shfl_xor(o4[e], 16); o4[e] += __shfl_xor(o4[e], 32); }
    const float inv = __builtin_amdgcn_rcpf(sum);
    if (kg == 0) { u32x2 w; w.x = cvt_pk_bf16(o4[0] * inv, o4[1] * inv); w.y = cvt_pk_bf16(o4[2] * inv, o4[3] * inv); *(u32x2*)(O + row * DM + hq * 64 + 4 * dq) = w; }
}
__device__ __forceinline__ void attn_phase(const Args& A, LAS unsigned char* lds, int jl, int tid, int lane, int wid) {
    const bf16* KFg = (const bf16*)(A.ws + WS_KF); const bf16* VTg = (const bf16*)(A.ws + WS_VT);
    for (int u = blockIdx.x; u < NB * 16 * 4; u += gridDim.x) { const int kvh = u & 3, qb = (u >> 2) & 15, b = u >> 6;
        const size_t bk = (size_t)b * 4 + kvh; const int q0 = qb * 128;
        __syncthreads();
#pragma unroll
        for (int j = 0; j < 4; ++j) { const int ci = tid + 512 * j, row = ci >> 3, part = ci & 7, t = q0 - 128 + row;
            if (t >= 0) *(LAS u32x4*)(lds + L_AK + row * KRS + part * 16) = *(const u32x4*)(KFg + (bk * SEQ + t) * 64 + part * 8); }
#pragma unroll
        for (int j = 0; j < 4; ++j) { const int ci = tid + 512 * j, row = ci >> 2, part = ci & 3, tile = (q0 - 128) / 32 + (row >> 6);
            if (tile >= 0) *(LAS u32x4*)(lds + L_AV + row * VRS + part * 16) = *(const u32x4*)(VTg + ((bk * 64 + tile) * 64 + (row & 63)) * 32 + part * 8); }
        __syncthreads();
        const int hq = kvh * 4 + (wid >> 1), r0 = q0 + (wid & 1) * 64, lt0 = 2 * (wid & 1);
        attn_prompt_tile(A, lds, lt0, jl, b, hq, r0, lane); attn_prompt_tile(A, lds, lt0 + 1, jl, b, hq, r0 + 32, lane); }
    __syncthreads();
    for (int it = blockIdx.x * 8 + wid; it < MS * 16; it += gridDim.x * 8) attn_sample_item(A, jl, it >> 4, it & 15, lane);
}

struct Thin { const bf16* A; const bf16* Wt; int K; int mode; const bf16* XBi; float* Xout; bf16* XBo; float* SSout; const float* SSin; bf16* PP; bf16* Q; float scale; };
typedef float f32x2v __attribute__((ext_vector_type(2)));
__device__ __forceinline__ void thin_gemm(LAS unsigned char* lds, const Thin& T, int tid, int lane, int wid, int bid) {
    if (bid >= 128) return;
    const int rt = bid >> 4, ct = bid & 15, fr = lane & 15, fq = lane >> 4;
    const int kw = T.K >> 3, k0 = wid * kw;
    const bf16* ap = T.A + (size_t)(MP + rt * 16 + fr) * T.K + k0 + 8 * fq;
    const bf16* bp = T.Wt + (size_t)(ct * 64 + fr) * T.K + k0 + 8 * fq;
    f32x4 acc[4];
#pragma unroll
    for (int c = 0; c < 4; ++c) acc[c] = (f32x4){0.f, 0.f, 0.f, 0.f};
#pragma unroll 2
    for (int k = 0; k < kw; k += 32) {
        const bf16x8 av = *(const bf16x8*)(ap + k);
#pragma unroll
        for (int c = 0; c < 4; ++c) { const bf16x8 bv = *(const bf16x8*)(bp + (size_t)c * 16 * T.K + k); acc[c] = __builtin_amdgcn_mfma_f32_16x16x32_bf16(av, bv, acc[c], 0, 0, 0); }
    }
    LAS float* red = (LAS float*)lds;
#pragma unroll
    for (int c = 0; c < 4; ++c)
#pragma unroll
        for (int r = 0; r < 4; ++r) red[(wid * 16 + 4 * fq + r) * 64 + c * 16 + fr] = acc[c][r];
    __syncthreads();
    const int row_l = tid >> 5, c2 = (tid & 31) * 2;
    f32x2v v = (f32x2v){0.f, 0.f};
#pragma unroll
    for (int w = 0; w < 8; ++w) v += *(const LAS f32x2v*)(red + (w * 16 + row_l) * 64 + c2);
    const int row = MP + rt * 16 + row_l, col = ct * 64 + c2; const size_t off = (size_t)row * DM + col;
    if (T.mode <= 1) {
        const unsigned xw = *(const unsigned*)(T.XBi + off); f32x2v x = (f32x2v){bflo(xw), bfhi(xw)};
        if (T.mode == 1) { const float rs = pg8::rstd_row(T.SSin, row); const unsigned pw = *(const unsigned*)(T.PP + off); x[0] += pg8::sigmoid_f(v[0] * rs) * bflo(pw); x[1] += pg8::sigmoid_f(v[1] * rs) * bfhi(pw); }
        else x += v * T.scale;
        float ssq = x[0] * x[0] + x[1] * x[1];
        if (T.Xout) *(f32x2v*)(T.Xout + off) = x;
        *(unsigned*)(T.XBo + off) = cvt_pk_bf16(x[0], x[1]);
        ssq += __shfl_xor(ssq, 1); ssq += __shfl_xor(ssq, 2); ssq += __shfl_xor(ssq, 4); ssq += __shfl_xor(ssq, 8); ssq += __shfl_xor(ssq, 16);
        if ((tid & 31) == 0) T.SSout[(size_t)row * 16 + ct] = ssq;
    } else if (T.mode == 2) { const float rs = pg8::rstd_row(T.SSin, row); *(unsigned*)(T.Q + off) = cvt_pk_bf16(v[0] * rs, v[1] * rs); }
    else *(unsigned*)(T.PP + off) = cvt_pk_bf16(v[0], v[1]);
    __syncthreads();
}

#define GEMM_RUN(EPI, g, E) do { pg8::StaticOrder S_; S_.init((g).M, (g).N, (int)gridDim.x, bid); pg8::gemm_phase<EPI, pg8::StaticOrder, true, true>(lds, (g), S_, (E), tid); } while (0)

__global__ void __launch_bounds__(512, 2) yoco_fwd(Args A_) {
    extern __shared__ __attribute__((aligned(16))) unsigned char lds_raw[];
    LAS unsigned char* lds = (LAS unsigned char*)lds_raw;
    const int wid = __builtin_amdgcn_readfirstlane((int)threadIdx.x >> 6);
    typedef const __attribute__((address_space(4))) Args* CArgsP;
    const int ph_lo = A_.ph_lo, ph_hi = A_.ph_hi;
    volatile LAS unsigned* MISC = (volatile LAS unsigned*)(lds + LDS_BYTES - 64);
    XcdBarrier gbar; gbar.bar = (unsigned*)(A_.ws + WS_BAR); gbar.x = 0; gbar.st = MISC;
    if (ph_hi - ph_lo > 1) {
        const int tid0 = (int)threadIdx.x;
        if (tid0 < 16) MISC[tid0] = 0u;
        __syncthreads();
        gbar = xcd_barrier_post((unsigned*)(A_.ws + WS_BAR), MISC, tid0);
    }
    for (int ph = ph_lo; ph < ph_hi; ++ph) {
        unsigned ones = ~0u; asm volatile("" : "+s"(ones));
        int lane_l = __builtin_amdgcn_mbcnt_hi(ones, __builtin_amdgcn_mbcnt_lo(ones, 0u)); asm volatile("" : "+v"(lane_l));
        CArgsP ap = (CArgsP)__builtin_amdgcn_kernarg_segment_ptr(); asm volatile("" : "+s"(ap));
        const Args& A = *(const Args*)ap;
        const int lane = lane_l, tid = wid * 64 + lane;
        int bid = (int)blockIdx.x; asm volatile("" : "+s"(bid));
        unsigned char* ws = A.ws;
        bf16* Hb = (bf16*)(ws + WS_H); bf16* PPb = (bf16*)(ws + WS_PP);
        if (ph == 0) { p0_prologue(A, lds, tid, lane, wid); }
        else {
            int L, s;
            if (ph <= 18) { L = (ph - 1) / 9; const int t = (ph - 1) % 9; s = t < 3 ? t : (t == 3 ? 9 : (t == 4 ? 3 : t)); } else { const int q = ph - 19; L = 2 + q / 8; s = q % 8; s = s < 4 ? s : s + 1; }
            const bool isA = L < 2; const int jl = L - 2;
            bf16* XB = (bf16*)(ws + ((L & 1) ? WS_XB2 : WS_XB)); bf16* XBn = (bf16*)(ws + ((L & 1) ? WS_XB : WS_XB2));
            float* SS0 = (float*)(ws + WS_SS); float* SS1 = (float*)(ws + WS_SS2);
            unsigned char* wl = ws + WS_W + (size_t)L * WL_STRIDE;
            if (s == 0 || s == 6) {
                pg8::Gemm g{XB, (const bf16*)(wl + (s == 0 ? WL_WI1 : WL_WI2)), MPAD, 2 * DFF, DM};
                pg8::EpiSwiGLU E{Hb, DFF, SS0};
                GEMM_RUN(pg8::EpiSwiGLU, g, E);
                if (s == 0 && L == 2) {
                    pg8::Gemm g2{XB, (const bf16*)(ws + WS_WKV), MPAD, 512, DM};
                    pg8::EpiF32 E2{(float*)(ws + WS_KVRAW), 512, SS0, nullptr};
                    GEMM_RUN(pg8::EpiF32, g2, E2);
                }
            } else if (s == 1 || s == 7) {
                if (s == 1 && L == 2) kv_finalize(A, lane, wid);
                pg8::Gemm g{Hb, (const bf16*)(wl + (s == 1 ? WL_WO1 : WL_WO2)), MP, DM, DFF};
                pg8::EpiRes E{XB, nullptr, XB, SS1, nullptr, nullptr, 0.5f, 0, MPAD};
                GEMM_RUN(pg8::EpiRes, g, E);
                Thin T{Hb, g.Bt, DFF, 0, XB, nullptr, XB, SS1, nullptr, nullptr, nullptr, 0.5f};
                thin_gemm(lds, T, tid, lane, wid, bid);
            } else if (s == 2) {
                if (isA) { pg8::Gemm g{XB, (const bf16*)(ws + WS_WA + (size_t)L * WA_STRIDE + WA_WIN), MPAD, NINP, DM};
                    pg8::EpiSplit E{(bf16*)(ws + WS_Z), DIN, 8, (bf16*)(ws + WS_XBC), CONVD, 24, (float*)(ws + WS_DT), SS1};
                    GEMM_RUN(pg8::EpiSplit, g, E);
                } else { pg8::Gemm g{XB, (const bf16*)(ws + WS_WB + (size_t)jl * WB_STRIDE + WB_WQ), MP, DM, DM};
                    pg8::EpiSplit E{(bf16*)(ws + WS_Q), DM, 4, (bf16*)(ws + WS_Q), DM, 4, (float*)(ws + WS_DT), SS1};
                    GEMM_RUN(pg8::EpiSplit, g, E);
                    Thin T{XB, g.Bt, DM, 2, nullptr, nullptr, nullptr, nullptr, SS1, nullptr, (bf16*)(ws + WS_Q), 1.0f};
                    thin_gemm(lds, T, tid, lane, wid, bid); }
            } else if (s == 3) {
                if (isA) ssd_phase(A, lds, L, tid, lane, wid); else attn_phase(A, lds, jl, tid, lane, wid);
            } else if (s == 9) {
                ssd_pre_phase(A, L, tid, lane, wid);
            } else if (s == 4) {
                if (isA) gnorm_phase(A, tid);
            } else if (s == 5) {
                pg8::Gemm g{isA ? (const bf16*)(ws + WS_YG) : (const bf16*)(ws + WS_O), isA ? (const bf16*)(ws + WS_WA + (size_t)L * WA_STRIDE + WA_WOUT) : (const bf16*)(ws + WS_WB + (size_t)jl * WB_STRIDE + WB_WO), MP, DM, isA ? DIN : DM};
                pg8::EpiRes E{XB, nullptr, XB, SS0, nullptr, nullptr, 1.0f, 0, MPAD};
                GEMM_RUN(pg8::EpiRes, g, E);
                Thin T{g.A, g.Bt, g.K, 0, XB, nullptr, XB, SS0, nullptr, nullptr, nullptr, 1.0f};
                thin_gemm(lds, T, tid, lane, wid, bid);
            } else {
                pg8::Gemm g1{(const bf16*)(ws + WS_P16) + (size_t)L * MPAD * DPLE, (const bf16*)(wl + WL_WP), MP, DM, DPLE};
                pg8::EpiF32 E1{nullptr, DM, nullptr, PPb};
                GEMM_RUN(pg8::EpiF32, g1, E1);
                pg8::Gemm g2{XB, (const bf16*)(wl + WL_WG), MP, DM, DM};
                const bool last = (L == NLAYER - 1);
                float* xo = last ? A.out + O_Y : nullptr;
                pg8::EpiRes E2{XB, xo, XBn, SS0, SS1, PPb, 1.0f, 1, MPAD};
                GEMM_RUN(pg8::EpiRes, g2, E2);
                Thin T1{g1.A, g1.Bt, DPLE, 3, nullptr, nullptr, nullptr, nullptr, nullptr, PPb, nullptr, 1.0f};
                thin_gemm(lds, T1, tid, lane, wid, bid);
                Thin T2{XB, g2.Bt, DM, 1, XB, xo, XBn, SS0, SS1, PPb, nullptr, 1.0f};
                thin_gemm(lds, T2, tid, lane, wid, bid);
            }
        }
        if (ph + 1 < ph_hi) {
            if (ph_hi < 0) cg::this_grid().sync();
            xcd_barrier(gbar, tid);
        }
    }
}

extern "C" void kernel_launch(void* const* d_in, const int* in_sizes, int n_in, void* d_out, int out_size, void* d_ws, size_t ws_size, hipStream_t stream) {
    static int grid = 0;
    if (grid == 0) {
        if (n_in != 33 || ws_size < WS_END) { fprintf(stderr, "kernel_launch: unexpected n_in %d or ws_size %zu (need %zu)\n", n_in, ws_size, (size_t)WS_END); grid = -1; return; }
        int dev = 0, cus = 0, per_cu = 0;
        hipGetDevice(&dev); hipDeviceGetAttribute(&cus, hipDeviceAttributeMultiprocessorCount, dev);
        if (hipFuncSetAttribute((const void*)yoco_fwd, hipFuncAttributeMaxDynamicSharedMemorySize, LDS_BYTES) != hipSuccess) { fprintf(stderr, "kernel_launch: hipFuncSetAttribute failed\n"); grid = -1; return; }
        if (hipOccupancyMaxActiveBlocksPerMultiprocessor(&per_cu, (const void*)yoco_fwd, 512, LDS_BYTES) != hipSuccess || per_cu < 1) { fprintf(stderr, "kernel_launch: occupancy query says %d\n", per_cu); per_cu = 1; }
        (void)hipGetLastError();
        grid = cus * 1;
        if (grid <= 0) grid = 256;
    }
    if (grid < 0) return;
    Args a{};
    for (int i = 0; i < 33; ++i) a.in[i] = (const float*)d_in[i];
    a.out = (float*)d_out; a.ws = (unsigned char*)d_ws;
#if MK_MULTI
    for (int ph = 0; ph < NPHASE; ++ph) {
        a.ph_lo = ph; a.ph_hi = ph + 1;
        hipLaunchKernelGGL(yoco_fwd, dim3(grid), dim3(512), LDS_BYTES, stream, a);
    }
#else
    (void)hipMemsetAsync((unsigned char*)d_ws + WS_BAR, 0, BAR_BYTES, stream);
    a.ph_lo = 0; a.ph_hi = NPHASE;
    void* args[] = {&a};
    hipError_t e = hipLaunchCooperativeKernel((const void*)yoco_fwd, dim3(grid), dim3(512), args, LDS_BYTES, stream);
    if (e != hipSuccess) fprintf(stderr, "cooperative launch failed: %s (grid %d)\n", hipGetErrorString(e), grid);
#endif
}
```

```cpp
#include <hip/hip_runtime.h>
#include <hip/hip_cooperative_groups.h>
#include <cstdio>
#include <cstdint>
namespace cg = cooperative_groups;
namespace pg8 {
#define PG8_LAS __attribute__((address_space(3)))
typedef unsigned short bf16_t;
typedef short bf16x8 __attribute__((ext_vector_type(8)));
typedef float f32x4 __attribute__((ext_vector_type(4)));
typedef unsigned u32x4 __attribute__((ext_vector_type(4)));
constexpr int BM = 256, BK = 64, HALF = 128, HTB = HALF * BK * 2  , STAGE_BYTES = 8 * HTB, NXCD = 8, WGM = 8;

__host__ __device__ __forceinline__ int lds_byte(int r, int c) { const int st = (r >> 4) * 2 + (c >> 5), rr = r & 15, cc = c & 31, ob = rr * 64 + cc * 2; return st * 1024 + (ob ^ (((ob >> 9) & 1) << 5)); }
__host__ __device__ __forceinline__ void stage_rc(int b, int& R, int& C) { const int st = b / 1024, sb = b % 1024, swz = sb ^ (((sb >> 9) & 1) << 5); R = (st >> 1) * 16 + swz / 64; C = (st & 1) * 32 + (swz % 64) / 2; }
__host__ __device__ __forceinline__ int perm32(int rho) { const int n = rho >> 4, i = rho & 15; return 8 * (i >> 2) + 4 * n + (i & 3); }

struct Unit { int pm, pn; };
struct Gemm { const bf16_t* A; const bf16_t* Bt; int M, N, K; };

struct StaticOrder {
    int nM, nN, nwg, G, c;
    __host__ __device__ void init(int M, int N, int G_, int c_) { nM = M / BM; nN = N / BM; nwg = nM * nN; G = G_; c = c_; }
    __host__ __device__ bool next(int i, Unit& u) const {
        const long L = (long)i * G + c; if (L >= nwg) return false;
        int wgid = (int)L; { const int q = nwg / NXCD, r = nwg % NXCD, xcd = wgid % NXCD, off = wgid / NXCD; wgid = (xcd < r ? xcd * (q + 1) : r * (q + 1) + (xcd - r) * q) + off; }
        const int nig = WGM * nN, gid = wgid / nig, fm = gid * WGM, gsz = (nM - fm) < WGM ? (nM - fm) : WGM;
        u.pm = fm + ((wgid % nig) % gsz); u.pn = (wgid % nig) / gsz; return true;
    }
    __device__ __forceinline__ void a_ready(const Unit&) const {}
    __device__ __forceinline__ void done(const Unit&) const {}
};


typedef float f32x2_t __attribute__((ext_vector_type(2)));
typedef __bf16 bf16x2_t __attribute__((ext_vector_type(2)));
__device__ __forceinline__ unsigned cvt_pk_bf16(float lo, float hi) { f32x2_t v = {lo, hi}; bf16x2_t b = __builtin_convertvector(v, bf16x2_t); return __builtin_bit_cast(unsigned, b); }
typedef unsigned u32x2 __attribute__((ext_vector_type(2)));
constexpr float RMS_EPS = 1e-6f;
__device__ __forceinline__ float rstd_row(const float* SS, int row) {
    const f32x4* p = (const f32x4*)(SS + (size_t)row * 16);
    const f32x4 a = p[0], b = p[1], c = p[2], d = p[3];
    const float s = ((a[0] + a[1]) + (a[2] + a[3])) + ((b[0] + b[1]) + (b[2] + b[3])) + ((c[0] + c[1]) + (c[2] + c[3])) + ((d[0] + d[1]) + (d[2] + d[3]));
    return __builtin_amdgcn_rsqf(s * (1.0f / 1024.0f) + RMS_EPS);
}
__device__ __forceinline__ float sigmoid_f(float v) { return __builtin_amdgcn_rcpf(1.0f + __expf(-v)); }

struct EpiSwiGLU {
    static constexpr bool PERM = true, AFTER_DRAIN = false;
    bf16_t* H; int ldh; const float* SS;
    __device__ __forceinline__ void operator()(const f32x4 (&acc)[2][2][4][2], const Unit& u, int wr, int wc, int fr, int fq) const {
        const int row0 = u.pm * BM + wr * 64 + fr; const int col0 = u.pn * 128 + wc * 32 + 8 * fq;
#pragma unroll
        for (int ai = 0; ai < 2; ++ai)
#pragma unroll
            for (int m = 0; m < 4; ++m) {
                const int row = row0 + ai * HALF + m * 16; const float rs = rstd_row(SS, row);
                float h[8];
#pragma unroll
                for (int n = 0; n < 2; ++n)
#pragma unroll
                    for (int e = 0; e < 4; ++e) { const float g = acc[ai][0][m][n][e] * rs, up = acc[ai][1][m][n][e] * rs; h[n * 4 + e] = g * sigmoid_f(g) * up; }
                u32x4 w; w.x = cvt_pk_bf16(h[0], h[1]); w.y = cvt_pk_bf16(h[2], h[3]); w.z = cvt_pk_bf16(h[4], h[5]); w.w = cvt_pk_bf16(h[6], h[7]);
                *(u32x4*)(H + (size_t)row * ldh + col0) = w;
            }
    }
};
struct EpiSplit {
    static constexpr bool PERM = true, AFTER_DRAIN = false;
    bf16_t* O0; int ld0; int t1; bf16_t* O1; int ld1; int t2; float* DT; const float* SS;
    __device__ __forceinline__ void operator()(const f32x4 (&acc)[2][2][4][2], const Unit& u, int wr, int wc, int fr, int fq) const {
        const int row0 = u.pm * BM + wr * 64 + fr;
        bf16_t* base; int ld, colt;
        if (u.pn < t1) { base = O0; ld = ld0; colt = u.pn * BM; } else { base = O1; ld = ld1; colt = (u.pn - t1) * BM; }
        const bool isdt = u.pn >= t2;
        const int col0 = colt + wc * 32 + 8 * fq;
#pragma unroll
        for (int ai = 0; ai < 2; ++ai)
#pragma unroll
            for (int m = 0; m < 4; ++m) {
                const int row = row0 + ai * HALF + m * 16; const float rs = rstd_row(SS, row);
                if (!isdt) {
#pragma unroll
                    for (int bj = 0; bj < 2; ++bj) { const f32x4 v0 = acc[ai][bj][m][0] * rs, v1 = acc[ai][bj][m][1] * rs;
                        u32x4 w; w.x = cvt_pk_bf16(v0[0], v0[1]); w.y = cvt_pk_bf16(v0[2], v0[3]); w.z = cvt_pk_bf16(v1[0], v1[1]); w.w = cvt_pk_bf16(v1[2], v1[3]);
                        *(u32x4*)(base + (size_t)row * ld + col0 + bj * HALF) = w; }
                } else if (wc == 0) {
                    float* d = DT + (size_t)row * 32 + 8 * fq;
                    *(f32x4*)d = acc[ai][0][m][0] * rs; *(f32x4*)(d + 4) = acc[ai][0][m][1] * rs;
                }
            }
    }
};
struct EpiF32 {
    static constexpr bool PERM = false, AFTER_DRAIN = false;
    float* O; int ldo; const float* SS; bf16_t* OB;
    __device__ __forceinline__ void operator()(const f32x4 (&acc)[2][2][4][2], const Unit& u, int wr, int wc, int fr, int fq) const {
        const int row0 = u.pm * BM + wr * 64 + fr; const int col0 = u.pn * BM + wc * 32 + 4 * fq;
#pragma unroll
        for (int ai = 0; ai < 2; ++ai)
#pragma unroll
            for (int m = 0; m < 4; ++m) {
                const int row = row0 + ai * HALF + m * 16; const float rs = SS ? rstd_row(SS, row) : 1.0f;
#pragma unroll
                for (int bj = 0; bj < 2; ++bj)
#pragma unroll
                    for (int n = 0; n < 2; ++n) { const f32x4 v = acc[ai][bj][m][n] * rs; const size_t o_ = (size_t)row * ldo + col0 + bj * HALF + n * 16;
                        if (OB) { u32x2 w; w.x = cvt_pk_bf16(v[0], v[1]); w.y = cvt_pk_bf16(v[2], v[3]); *(u32x2*)(OB + o_) = w; } else *(f32x4*)(O + o_) = v; }
            }
    }
};
struct EpiRes {
    static constexpr bool PERM = false, AFTER_DRAIN = false;
    const bf16_t* XBin; float* Xout; bf16_t* XB; float* SSout; const float* SSin; const bf16_t* PP; float scale; int mode; int mreal;
    __device__ __forceinline__ void operator()(const f32x4 (&acc)[2][2][4][2], const Unit& u, int wr, int wc, int fr, int fq) const {
        const int row0 = u.pm * BM + wr * 64 + fr; const int col0 = u.pn * BM + wc * 32 + 4 * fq;
#pragma unroll
        for (int ai = 0; ai < 2; ++ai)
#pragma unroll
            for (int m = 0; m < 4; ++m) {
                const int row = row0 + ai * HALF + m * 16; const size_t off = (size_t)row * 1024 + col0;
                const float rs = (mode == 1) ? rstd_row(SSin, row) : 0.0f;
                float ssq = 0.f;
#pragma unroll
                for (int bj = 0; bj < 2; ++bj)
#pragma unroll
                    for (int n = 0; n < 2; ++n) {
                        const u32x2 xb = *(const u32x2*)(XBin + off + bj * HALF + n * 16); const f32x4 a = acc[ai][bj][m][n];
                        f32x4 x4 = (f32x4){__uint_as_float(xb.x << 16), __uint_as_float(xb.x & 0xffff0000u), __uint_as_float(xb.y << 16), __uint_as_float(xb.y & 0xffff0000u)};
                        if (mode == 1) { const u32x2 pw = *(const u32x2*)(PP + off + bj * HALF + n * 16);
                            const f32x4 p4 = (f32x4){__uint_as_float(pw.x << 16), __uint_as_float(pw.x & 0xffff0000u), __uint_as_float(pw.y << 16), __uint_as_float(pw.y & 0xffff0000u)};
#pragma unroll
                            for (int e = 0; e < 4; ++e) x4[e] += sigmoid_f(a[e] * rs) * p4[e];
                        } else x4 += a * scale;
                        ssq += (x4[0] * x4[0] + x4[1] * x4[1]) + (x4[2] * x4[2] + x4[3] * x4[3]);
                        if (Xout) *(f32x4*)(Xout + off + bj * HALF + n * 16) = x4;
                        u32x2 w; w.x = cvt_pk_bf16(x4[0], x4[1]); w.y = cvt_pk_bf16(x4[2], x4[3]); *(u32x2*)(XB + off + bj * HALF + n * 16) = w;
                    }
                ssq += __shfl_xor(ssq, 16); ssq += __shfl_xor(ssq, 32);
                if (fq == 0) SSout[(size_t)row * 16 + u.pn * 4 + wc] = ssq;
                if (m & 1) asm volatile("" ::: "memory");
            }
    }
};

template <class Epi, class Sched, bool ALIGN_EPI = false, bool SP2 = false>
__device__ __forceinline__ void gemm_phase(PG8_LAS unsigned char* lds, const Gemm g, const Sched& S, const Epi& E, int tid_in) {
    int tid_l = tid_in; asm volatile("" : "+v"(tid_l));
    const int tid = tid_l, wid = __builtin_amdgcn_readfirstlane(tid >> 6), lane = tid & 63, wr = wid >> 2, wc = wid & 3, fr = lane & 15, fq = lane >> 4;
    const int K = g.K, nt = K / BK;
    unsigned voffA[2], voffB[2];
#pragma unroll
    for (int i = 0; i < 2; ++i) { int R, C; stage_rc(tid * 16 + i * 8192, R, C); const int Rb = Epi::PERM ? ((R & ~31) + perm32(R & 31)) : R;
        voffA[i] = (unsigned)(R * K + C) * 2u; voffB[i] = (unsigned)(Rb * K + C) * 2u; }
    const size_t kstep = (size_t)(BK * 2);
    const size_t hstep = (size_t)HALF * K * 2;
    const size_t tstep = 2 * hstep;
    const unsigned ldsw = (unsigned)wid * 1024u;
    const int aoff = lds_byte(wr * 64 + fr, fq * 8), boff = lds_byte(wc * 32 + fr, fq * 8);
#define PG8_SA(b, h) (((b) * 2 + (h)) * HTB)
#define PG8_SB(b, h) ((4 + (b) * 2 + (h)) * HTB)
#define PG8_STAGE(bufoff, gbase, voff) do { _Pragma("unroll") for (int _i = 0; _i < 2; ++_i) \
        __builtin_amdgcn_global_load_lds((const unsigned*)((const char*)(gbase) + (voff)[_i]), (PG8_LAS unsigned*)(lds + (bufoff) + ldsw + _i * 8192), 16, 0, 0); } while (0)
#define PG8_LDA(dst, b, h) do { _Pragma("unroll") for (int m = 0; m < 4; ++m) _Pragma("unroll") for (int k = 0; k < 2; ++k) dst[m][k] = *(const PG8_LAS bf16x8*)(lds + PG8_SA(b, h) + aoff + m * 2048 + k * 1024); } while (0)
#define PG8_LDB(dst, b, h) do { _Pragma("unroll") for (int n = 0; n < 2; ++n) _Pragma("unroll") for (int k = 0; k < 2; ++k) dst[n][k] = *(const PG8_LAS bf16x8*)(lds + PG8_SB(b, h) + boff + n * 2048 + k * 1024); } while (0)
#define PG8_MMA(ai, bj, At, Bt) do { __builtin_amdgcn_s_setprio(1); _Pragma("unroll") for (int m = 0; m < 4; ++m) _Pragma("unroll") for (int n = 0; n < 2; ++n) _Pragma("unroll") for (int k = 0; k < 2; ++k) \
        acc[ai][bj][m][n] = __builtin_amdgcn_mfma_f32_16x16x32_bf16(Bt[n][k], At[m][k], acc[ai][bj][m][n], 0, 0, 0); __builtin_amdgcn_s_setprio(0); } while (0)
#define PG8_WAIT_V(n) asm volatile("s_waitcnt vmcnt(" #n ")" ::: "memory")
#define PG8_WAIT_L(n) asm volatile("s_waitcnt lgkmcnt(" #n ")" ::: "memory")
#define PG8_BAR __builtin_amdgcn_s_barrier()
#define PG8_SCHED __builtin_amdgcn_sched_barrier(0)
    Unit cur, nxt; int ui = 0;
    if (!S.next(0, cur)) return;
    f32x4 acc[2][2][4][2];
#pragma unroll
    for (int a = 0; a < 2; ++a)
#pragma unroll
        for (int b = 0; b < 2; ++b)
#pragma unroll
            for (int m = 0; m < 4; ++m)
#pragma unroll
                for (int n = 0; n < 2; ++n) acc[a][b][m][n] = (f32x4){0.f, 0.f, 0.f, 0.f};
    bf16x8 At[4][2], B0[2][2], B1[2][2];
    const char* cA = (const char*)g.A + (size_t)cur.pm * tstep; const char* cB = (const char*)g.Bt + (size_t)cur.pn * tstep;
    S.a_ready(cur);
    if constexpr (SP2) {
        PG8_STAGE(PG8_SB(0, 0), cB, voffB); PG8_STAGE(PG8_SB(0, 1), cB + hstep, voffB); PG8_STAGE(PG8_SA(0, 0), cA, voffA); PG8_STAGE(PG8_SA(0, 1), cA + hstep, voffA);
        if (wr == 1) PG8_BAR;
        PG8_WAIT_V(2); PG8_BAR;
        PG8_STAGE(PG8_SB(1, 0), cB + kstep, voffB); PG8_STAGE(PG8_SA(1, 0), cA + kstep, voffA); PG8_STAGE(PG8_SB(1, 1), cB + hstep + kstep, voffB);
        PG8_WAIT_V(6); PG8_BAR;
    } else {
        PG8_STAGE(PG8_SB(0, 0), cB, voffB); PG8_STAGE(PG8_SA(0, 0), cA, voffA); PG8_STAGE(PG8_SB(0, 1), cB + hstep, voffB); PG8_STAGE(PG8_SA(0, 1), cA + hstep, voffA);
        if (wr == 1) PG8_BAR;
        PG8_WAIT_V(4); PG8_BAR;
        PG8_STAGE(PG8_SB(1, 0), cB + kstep, voffB); PG8_STAGE(PG8_SA(1, 0), cA + kstep, voffA); PG8_STAGE(PG8_SB(1, 1), cB + hstep + kstep, voffB);
        PG8_WAIT_V(6); PG8_BAR;
    }
    for (;;) {
        const bool has_next = S.next(ui + 1, nxt);
        const char* nA = has_next ? (const char*)g.A + (size_t)nxt.pm * tstep : cA; const char* nB = has_next ? (const char*)g.Bt + (size_t)nxt.pn * tstep : cB;
        for (int t = 0; t < nt; t += 2) {
            const bool last = (t == nt - 2);
            const char* a1 = cA + (size_t)(t + 1) * kstep;
            const char* a2 = last ? nA : cA + (size_t)(t + 2) * kstep; const char* b2 = last ? nB : cB + (size_t)(t + 2) * kstep;
            const char* a3 = a2 + kstep; const char* b3 = b2 + kstep;
            if (last && has_next) S.a_ready(nxt);
            if constexpr (SP2) {
            PG8_LDB(B0, 0, 0); PG8_LDB(B1, 0, 1); PG8_SCHED; PG8_LDA(At, 0, 0); PG8_STAGE(PG8_SA(1, 1), a1 + hstep, voffA);
            PG8_WAIT_V(8); PG8_WAIT_L(0); PG8_BAR; PG8_MMA(0, 0, At, B0); PG8_MMA(0, 1, At, B1); PG8_BAR; PG8_SCHED;
            PG8_LDA(At, 0, 1); PG8_STAGE(PG8_SB(0, 0), b2, voffB); PG8_STAGE(PG8_SB(0, 1), b2 + hstep, voffB); PG8_STAGE(PG8_SA(0, 0), a2, voffA);
            PG8_WAIT_V(8); PG8_WAIT_L(0); PG8_BAR; PG8_MMA(1, 0, At, B0); PG8_MMA(1, 1, At, B1); PG8_BAR; PG8_SCHED;
            PG8_LDB(B0, 1, 0); PG8_LDB(B1, 1, 1); PG8_SCHED; PG8_LDA(At, 1, 0); PG8_STAGE(PG8_SA(0, 1), a2 + hstep, voffA);
            PG8_WAIT_V(8); PG8_WAIT_L(0); PG8_BAR; PG8_MMA(0, 0, At, B0); PG8_MMA(0, 1, At, B1); PG8_BAR; PG8_SCHED;
            PG8_LDA(At, 1, 1); PG8_STAGE(PG8_SB(1, 0), b3, voffB); PG8_STAGE(PG8_SB(1, 1), b3 + hstep, voffB); PG8_STAGE(PG8_SA(1, 0), a3, voffA);
            PG8_WAIT_V(8); PG8_WAIT_L(0); PG8_BAR; PG8_MMA(1, 0, At, B0); PG8_MMA(1, 1, At, B1); PG8_BAR; PG8_SCHED;
            } else {
            PG8_LDB(B0, 0, 0); PG8_SCHED; PG8_LDA(At, 0, 0); PG8_STAGE(PG8_SA(1, 1), a1 + hstep, voffA);
            PG8_WAIT_L(8); PG8_BAR; PG8_WAIT_L(0); PG8_MMA(0, 0, At, B0); PG8_BAR; PG8_SCHED;
            PG8_LDB(B1, 0, 1); PG8_STAGE(PG8_SB(0, 0), b2, voffB);
            PG8_BAR; PG8_WAIT_L(0); PG8_MMA(0, 1, At, B1); PG8_BAR;
            PG8_LDA(At, 0, 1); PG8_STAGE(PG8_SA(0, 0), a2, voffA);
            PG8_BAR; PG8_WAIT_L(0); PG8_MMA(1, 0, At, B0); PG8_BAR; PG8_SCHED;
            PG8_STAGE(PG8_SB(0, 1), b2 + hstep, voffB);
            PG8_WAIT_V(6); PG8_BAR; PG8_MMA(1, 1, At, B1); PG8_BAR;
            PG8_LDB(B0, 1, 0); PG8_SCHED; PG8_LDA(At, 1, 0); PG8_STAGE(PG8_SA(0, 1), a2 + hstep, voffA);
            PG8_WAIT_L(8); PG8_BAR; PG8_WAIT_L(0); PG8_MMA(0, 0, At, B0); PG8_BAR; PG8_SCHED;
            PG8_LDB(B1, 1, 1); PG8_STAGE(PG8_SB(1, 0), b3, voffB);
            PG8_BAR; PG8_WAIT_L(0); PG8_MMA(0, 1, At, B1); PG8_BAR;
            PG8_LDA(At, 1, 1); PG8_STAGE(PG8_SA(1, 0), a3, voffA);
            PG8_BAR; PG8_WAIT_L(0); PG8_MMA(1, 0, At, B0); PG8_BAR; PG8_SCHED;
            PG8_STAGE(PG8_SB(1, 1), b3 + hstep, voffB);
            PG8_WAIT_V(6); PG8_BAR; PG8_MMA(1, 1, At, B1); PG8_BAR;
            }
        }
        if constexpr (ALIGN_EPI) { if (wr == 0) PG8_BAR; }
        if constexpr (!Epi::AFTER_DRAIN) { E(acc, cur, wr, wc, fr, fq); S.done(cur); }
        if (!has_next) break;
#pragma unroll
        for (int a = 0; a < 2; ++a)
#pragma unroll
            for (int b = 0; b < 2; ++b)
#pragma unroll
                for (int m = 0; m < 4; ++m)
#pragma unroll
                    for (int n = 0; n < 2; ++n) acc[a][b][m][n] = (f32x4){0.f, 0.f, 0.f, 0.f};
        cur = nxt; cA = nA; cB = nB; ++ui;
        if constexpr (ALIGN_EPI) { if (wr == 1) PG8_BAR; }
    }
    PG8_WAIT_V(0);
    if constexpr (!ALIGN_EPI) { if (wr == 0) PG8_BAR; }
    PG8_BAR;
    if constexpr (Epi::AFTER_DRAIN) { E.fused(acc, cur, wr, wc, fr, fq, lds, wid, lane); S.done(cur); }
#undef PG8_SA
#undef PG8_SB
#undef PG8_STAGE
#undef PG8_LDA
#undef PG8_LDB
#undef PG8_MMA
#undef PG8_WAIT_V
#undef PG8_WAIT_L
#undef PG8_BAR
#undef PG8_SCHED
}
}

#define LAS __attribute__((address_space(3)))
#define XB_TMO      128
#define XB_XCNT(j)  (256  + 64 * (j))
#define XB_XSUB(j)  (1280 + 64 * (j))
#define XB_XGEN(j)  (2304 + 64 * (j))
#define XB_TOP      3328
#define XB_TOPGEN   3392
#define XCD_BAR_WORDS 3456
#define XB_SPIN_CAP (1u << 18)

__device__ __forceinline__ unsigned xb_ld(unsigned* p)              { return __hip_atomic_load(p, __ATOMIC_RELAXED, __HIP_MEMORY_SCOPE_AGENT); }
__device__ __forceinline__ unsigned xb_add(unsigned* p, unsigned v) { return __hip_atomic_fetch_add(p, v, __ATOMIC_RELAXED, __HIP_MEMORY_SCOPE_AGENT); }
__device__ __forceinline__ unsigned xb_xcc_id() { return (unsigned)__builtin_amdgcn_s_getreg((3 << 11) | 20) & 0xFu; }
#define XB_SPIN(cond, bar) do { unsigned _sp = 0; while (cond) { __builtin_amdgcn_s_sleep(1); \
    if ((++_sp & 255u) == 0u) { if (xb_ld(&(bar)[XB_TMO])) break; if (_sp > XB_SPIN_CAP) { atomicAdd(&(bar)[XB_TMO], 1u); break; } } } } while (0)

struct XcdBarrier {
    unsigned* bar; unsigned x;
    volatile LAS unsigned* st;
};

__device__ __forceinline__ XcdBarrier xcd_barrier_post(unsigned* bar, volatile LAS unsigned* st, int tid) {
    XcdBarrier b; b.bar = bar; b.x = xb_xcc_id(); b.st = st;
    if (tid == 0) (void)xb_add(&bar[XB_XCNT(b.x)], 1u);
    return b;
}
__device__ __forceinline__ void xcd_barrier_complete(unsigned* bar, unsigned x, unsigned& nloc, unsigned& nx) {
    const unsigned G = gridDim.x * gridDim.y * gridDim.z;
    unsigned sum, cnt, mine, sp = 0u;
    for (;;) {
        sum = 0u; cnt = 0u; mine = 0u;
#pragma unroll
        for (unsigned j = 0; j < 16; ++j) { const unsigned c = xb_ld(&bar[XB_XCNT(j)]); sum += c; cnt += (c > 0u) ? 1u : 0u; mine = (j == x) ? c : mine; }
        if (sum == G) break;
        __builtin_amdgcn_s_sleep(1);
        if ((++sp & 255u) == 0u) { if (xb_ld(&bar[XB_TMO])) break; if (sp > XB_SPIN_CAP) { atomicAdd(&bar[XB_TMO], 1u); break; } }
    }
    nloc = mine > 0u ? mine : 1u; nx = cnt > 0u ? cnt : 1u;
}

__device__ __forceinline__ void xcd_barrier(const XcdBarrier& b, int tid) {
    asm volatile("s_waitcnt vmcnt(0)" ::: "memory");
    __syncthreads();
    if (tid == 0) {
        unsigned* bar = b.bar;
        __builtin_amdgcn_s_waitcnt(0);
        unsigned nloc = b.st[0], nx = b.st[1];
        if (nloc == 0u) { xcd_barrier_complete(bar, b.x, nloc, nx); b.st[0] = nloc; b.st[1] = nx; }
        const unsigned old = xb_add(&bar[XB_XSUB(b.x)], 1u);
        const unsigned gen = old / nloc;
        if (old + 1u == (gen + 1u) * nloc) {
            __builtin_amdgcn_fence(__ATOMIC_RELEASE, "agent");
            asm volatile("s_waitcnt vmcnt(0)" ::: "memory");
            const unsigned og = xb_add(&bar[XB_TOP], 1u);
            const unsigned tg = og / nx;
            if (og + 1u == (tg + 1u) * nx) xb_add(&bar[XB_TOPGEN], 1u);
            else XB_SPIN(xb_ld(&bar[XB_TOPGEN]) == tg, bar);
            __builtin_amdgcn_fence(__ATOMIC_ACQUIRE, "agent");
            xb_add(&bar[XB_XGEN(b.x)], 1u);
            asm volatile("s_waitcnt vmcnt(0)" ::: "memory");
        } else {
            XB_SPIN(xb_ld(&bar[XB_XGEN(b.x)]) == gen, bar);
            __builtin_amdgcn_fence(__ATOMIC_ACQUIRE, "agent");
            asm volatile("s_waitcnt vmcnt(0)" ::: "memory");
        }
    }
    __syncthreads();
}


#ifndef MK_MULTI
#define MK_MULTI 0
#endif
constexpr int DM = 1024, NB = 8, SEQ = 2048, MP = NB * SEQ, MS = 128, MR = MP + MS, MPAD = 16640;
constexpr int DFF = 2816, DPLE = 256, DIN = 2048, CONVD = 4096, NH = 32, DST = 128;
constexpr int NIN = 6176, NINP = 6400, NLAYER = 4;
constexpr int PAST = 8192;
constexpr size_t MiB = 1u << 20;
constexpr size_t WS_SS = 0, WS_ROPE = 2 * MiB, WS_GSQ = 3 * MiB, WS_DT = 8 * MiB, WS_KF = 12 * MiB, WS_VT = 20 * MiB, WS_KVRAW = 28 * MiB;
constexpr size_t WS_X = 62 * MiB, WS_XB = 128 * MiB, WS_H = 162 * MiB, WS_PP = 252 * MiB, WS_P16 = 318 * MiB, WS_Z = 352 * MiB, WS_XBC = 418 * MiB, WS_YG = 548 * MiB;
constexpr size_t WS_Q = WS_Z, WS_O = WS_Z + 33 * MiB;
constexpr size_t WS_W = 614 * MiB;
constexpr size_t WL_STRIDE = 36 * MiB, WL_WI1 = 0, WL_WO1 = 11 * MiB, WL_WI2 = 17 * MiB, WL_WO2 = 28 * MiB, WL_WG = 34 * MiB - 512 * 1024, WL_WP = 36 * MiB - 512 * 1024;
constexpr size_t WS_WA = WS_W + 4 * WL_STRIDE, WA_STRIDE = 17 * MiB, WA_WIN = 0, WA_WOUT = 13 * MiB;
constexpr size_t WS_WB = WS_WA + 2 * WA_STRIDE, WB_STRIDE = 4 * MiB, WB_WQ = 0, WB_WO = 2 * MiB;
constexpr size_t WS_WKV = WS_WB + 2 * WB_STRIDE;
constexpr size_t WS_SS2 = WS_WKV + 1 * MiB, WS_XB2 = WS_SS2 + 2 * MiB;
constexpr size_t WS_BAR = WS_XB2 + 33 * MiB, BAR_BYTES = 65536;
constexpr size_t WS_END = WS_BAR + 1 * MiB;
static_assert(WS_END <= 1024 * MiB, "ws");
constexpr size_t O_Y = 0, O_SSMP = 16908288, O_CONVP = 21102592, O_KP = 21299200, O_VP = 21561344, O_SSMS = 21823488, O_CONVS = 88932352, O_KS = 92078080, O_VS = 96272384;
constexpr int LDS_BYTES = 160 * 1024;
constexpr int NPHASE = 1 + 2 * 10 + 2 * 8;

typedef unsigned short bf16;
typedef float f32x4 __attribute__((ext_vector_type(4)));
typedef float f32x16 __attribute__((ext_vector_type(16)));
typedef short bf16x8 __attribute__((ext_vector_type(8)));
typedef unsigned u32x4 __attribute__((ext_vector_type(4)));
typedef unsigned u32x2 __attribute__((ext_vector_type(2)));
using pg8::cvt_pk_bf16;
__device__ __forceinline__ float bflo(unsigned w) { return __uint_as_float(w << 16); }
__device__ __forceinline__ float bfhi(unsigned w) { return __uint_as_float(w & 0xffff0000u); }
__device__ __forceinline__ float bf1(bf16 h) { return __uint_as_float((unsigned)h << 16); }
__device__ __forceinline__ bf16 f2bf(float f) { return (bf16)(cvt_pk_bf16(f, 0.f) & 0xffffu); }
__device__ __forceinline__ float silu_f(float v) { return v * __builtin_amdgcn_rcpf(1.0f + __expf(-v)); }
__device__ __forceinline__ float wave_sum(float v) {
#pragma unroll
    for (int o = 1; o < 64; o <<= 1) v += __shfl_xor(v, o);
    return v;
}
__device__ __forceinline__ float wave_max(float v) {
#pragma unroll
    for (int o = 1; o < 64; o <<= 1) v = fmaxf(v, __shfl_xor(v, o));
    return v;
}
#define LDS_WAIT() asm volatile("s_waitcnt lgkmcnt(0)" ::: "memory")

struct Args { const float* in[33]; float* out; unsigned char* ws; int ph_lo, ph_hi; };
enum { I_XP = 0, I_XS, I_SSM, I_CONV, I_CK, I_CV, I_PP, I_PS, I_F1N, I_F1WI, I_F1WO, I_MIXN, I_F2N, I_F2WI, I_F2WO, I_PLEN, I_PLEG, I_PLEP,
       I_SIN, I_SCW, I_SCB, I_SDTB, I_SALOG, I_SD, I_SNORM, I_SOUT, I_KVN, I_WKV, I_KN, I_WQ, I_QN, I_SINK, I_WO };

__device__ __forceinline__ void tr_load(const float* W, int N, const float* gain, int item, int lane, float (&v)[32], float& gv) {
    const int nblk = N / 32, kb = item / nblk, nb = item % nblk, k0 = 64 * kb, n0 = 32 * nb;
    const float* wp = W + (size_t)(k0 + (lane >> 5)) * N + n0 + (lane & 31);
#pragma unroll
    for (int i = 0; i < 32; ++i) v[i] = wp[(size_t)(2 * i) * N];
    gv = gain ? gain[k0 + lane] : 1.0f;
}
__device__ __forceinline__ void tr_finish(float (&v)[32], float gv, int K, int N, bf16* WT, int mode, LAS float* scr, int item, int lane) {
    const int nblk = N / 32, kb = item / nblk, nb = item % nblk, k0 = 64 * kb, n0 = 32 * nb;
    int drow0 = n0;
    if (mode == 1) { if (n0 < DFF) drow0 = 256 * (n0 / 128) + (n0 % 128); else { const int j = n0 - DFF; drow0 = 256 * (j / 128) + 128 + (j % 128); } }
#pragma unroll
    for (int i = 0; i < 32; ++i) { const float g0 = __builtin_bit_cast(float, __builtin_amdgcn_readlane(__builtin_bit_cast(int, gv), 2 * i)), g1 = __builtin_bit_cast(float, __builtin_amdgcn_readlane(__builtin_bit_cast(int, gv), 2 * i + 1));
        scr[(2 * i + (lane >> 5)) * 33 + (lane & 31)] = v[i] * ((lane >> 5) ? g1 : g0); }
    LDS_WAIT(); asm volatile("" ::: "memory");
    const int c = lane & 7;
#pragma unroll
    for (int j = 0; j < 4; ++j) { const int n = (lane >> 3) + 8 * j; const LAS float* sp = scr + (8 * c) * 33 + n;
        u32x4 o; o.x = cvt_pk_bf16(sp[0 * 33], sp[1 * 33]); o.y = cvt_pk_bf16(sp[2 * 33], sp[3 * 33]); o.z = cvt_pk_bf16(sp[4 * 33], sp[5 * 33]); o.w = cvt_pk_bf16(sp[6 * 33], sp[7 * 33]);
        *(u32x4*)(WT + (size_t)(drow0 + n) * K + k0 + 8 * c) = o; }
    LDS_WAIT(); asm volatile("" ::: "memory");
}
__constant__ double ROPE_T8[8] = {1.0, 0.7498942093324559, 0.5623413251903491, 0.4216965034285822, 0.31622776601683794, 0.23713737056616552, 0.1778279410038923, 0.1333521432163324};
__constant__ double ROPE_P10[4] = {1.0, 0.1, 0.01, 0.001};

__device__ __forceinline__ void convert_weights(const Args& A, LAS unsigned char* lds, int lane, int wave, unsigned long long mask, int widx, int nw) {
    unsigned char* ws = A.ws;
    LAS float* scr = (LAS float*)(lds + wave * 16384);
#pragma unroll 1
    for (int job = 0; job < 33; ++job) {
        if (!((mask >> job) & 1ull)) continue;
        const float* src; bf16* dst; const float* gain = nullptr; int K, N, mode = 0;
        if (job < 24) { const int L = job / 6, k = job % 6; unsigned char* wl = ws + WS_W + (size_t)L * WL_STRIDE;
            if (k == 0)      { src = A.in[I_F1WI] + (size_t)L * DM * 2 * DFF; dst = (bf16*)(wl + WL_WI1); gain = A.in[I_F1N] + L * DM; K = DM; N = 2 * DFF; mode = 1; }
            else if (k == 1) { src = A.in[I_F1WO] + (size_t)L * DFF * DM;     dst = (bf16*)(wl + WL_WO1); K = DFF; N = DM; }
            else if (k == 2) { src = A.in[I_F2WI] + (size_t)L * DM * 2 * DFF; dst = (bf16*)(wl + WL_WI2); gain = A.in[I_F2N] + L * DM; K = DM; N = 2 * DFF; mode = 1; }
            else if (k == 3) { src = A.in[I_F2WO] + (size_t)L * DFF * DM;     dst = (bf16*)(wl + WL_WO2); K = DFF; N = DM; }
            else if (k == 4) { src = A.in[I_PLEG] + (size_t)L * DM * DM;      dst = (bf16*)(wl + WL_WG); gain = A.in[I_PLEN] + L * DM; K = DM; N = DM; }
            else             { src = A.in[I_PLEP] + (size_t)L * DPLE * DM;    dst = (bf16*)(wl + WL_WP); K = DPLE; N = DM; }
        } else if (job < 28) { const int a = (job - 24) / 2, k = (job - 24) % 2; unsigned char* wl = ws + WS_WA + (size_t)a * WA_STRIDE;
            if (k == 0) { src = A.in[I_SIN] + (size_t)a * DM * NIN;  dst = (bf16*)(wl + WA_WIN); gain = A.in[I_MIXN] + a * DM; K = DM; N = NIN; }
            else        { src = A.in[I_SOUT] + (size_t)a * DIN * DM; dst = (bf16*)(wl + WA_WOUT); gain = A.in[I_SNORM] + a * DIN; K = DIN; N = DM; }
        } else if (job < 32) { const int bb = (job - 28) / 2, k = (job - 28) % 2; unsigned char* wl = ws + WS_WB + (size_t)bb * WB_STRIDE;
            if (k == 0) { src = A.in[I_WQ] + (size_t)bb * DM * DM; dst = (bf16*)(wl + WB_WQ); gain = A.in[I_MIXN] + (2 + bb) * DM; K = DM; N = DM; }
            else        { src = A.in[I_WO] + (size_t)bb * DM * DM; dst = (bf16*)(wl + WB_WO); K = DM; N = DM; }
        } else { src = A.in[I_WKV]; dst = (bf16*)(ws + WS_WKV); gain = A.in[I_KVN]; K = DM; N = 512; }
        const int nitems = (K / 64) * (N / 32);
        for (int it = widx; it < nitems; it += 2 * nw) {
            const int it2 = it + nw; const bool two = it2 < nitems;
            float va[32], vb[32], ga, gb = 1.0f;
            tr_load(src, N, gain, it, lane, va, ga);
            if (two) tr_load(src, N, gain, it2, lane, vb, gb);
            tr_finish(va, ga, K, N, dst, mode, scr, it, lane);
            if (two) tr_finish(vb, gb, K, N, dst, mode, scr, it2, lane);
        }
    }
}
constexpr unsigned long long PROLOGUE_JOBS = 0x3Full | (3ull << 24);
__device__ __forceinline__ unsigned long long tail_jobs(int L, int s) {
    if (L > 2) return 0ull;
    if (s == 0) return (3ull << (6 * (L + 1))) | (L == 2 ? (3ull << 30) : 0ull);
    if (s == 6) return 0xFull << (6 * (L + 1) + 2);
    if (s == 2) return L == 0 ? (3ull << 26) : (L == 1 ? ((3ull << 28) | (1ull << 32)) : 0ull);
    return 0ull;
}

__device__ __forceinline__ void p0_prologue(const Args& A, LAS unsigned char* lds, int tid, int lane, int wave) {
    unsigned char* ws = A.ws;
    const int gw = blockIdx.x * 8 + wave, NGW = gridDim.x * 8;
    const int gt = blockIdx.x * 512 + tid, NGT = gridDim.x * 512;
    convert_weights(A, lds, lane, wave, PROLOGUE_JOBS, gw, NGW);
    for (int i = gt; i < 2 * (NINP - NIN) * DM / 8; i += NGT) { const int a = i / ((NINP - NIN) * DM / 8), r = i % ((NINP - NIN) * DM / 8);
        *(u32x4*)((bf16*)(ws + WS_WA + (size_t)a * WA_STRIDE + WA_WIN) + (size_t)NIN * DM + (size_t)r * 8) = (u32x4){0u, 0u, 0u, 0u}; }
    bf16* XB = (bf16*)(ws + WS_XB); float* SS = (float*)(ws + WS_SS);
    for (int m = gw; m < MPAD; m += NGW) {
        f32x4 v[4]; float s = 0.f;
        if (m < MR) { const float* xr = (m < MP) ? A.in[I_XP] + (size_t)m * DM : A.in[I_XS] + (size_t)(m - MP) * DM;
#pragma unroll
            for (int j = 0; j < 4; ++j) { v[j] = ((const f32x4*)xr)[lane + 64 * j]; s += (v[j][0] * v[j][0] + v[j][1] * v[j][1]) + (v[j][2] * v[j][2] + v[j][3] * v[j][3]); }
        } else {
#pragma unroll
            for (int j = 0; j < 4; ++j) v[j] = (f32x4){0.f, 0.f, 0.f, 0.f};
        }
        s = wave_sum(s);
#pragma unroll
        for (int j = 0; j < 4; ++j) {
            u32x2 w; w.x = cvt_pk_bf16(v[j][0], v[j][1]); w.y = cvt_pk_bf16(v[j][2], v[j][3]); ((u32x2*)(XB + (size_t)m * DM))[lane + 64 * j] = w; }
        if (lane < 16) SS[(size_t)m * 16 + lane] = (lane == 0) ? s : 0.f;
    }
    bf16* P16 = (bf16*)(ws + WS_P16);
    for (int r4 = gw; r4 < NLAYER * MPAD / 4; r4 += NGW) {
        f32x4 v[4];
#pragma unroll
        for (int q = 0; q < 4; ++q) { const int r = r4 * 4 + q, L = r / MPAD, m = r % MPAD; v[q] = (f32x4){0.f, 0.f, 0.f, 0.f};
            if (m < MP) v[q] = ((const f32x4*)(A.in[I_PP] + ((size_t)L * MP + m) * DPLE))[lane]; else if (m < MR) v[q] = ((const f32x4*)(A.in[I_PS] + ((size_t)L * MS + (m - MP)) * DPLE))[lane]; }
#pragma unroll
        for (int q = 0; q < 4; ++q) { u32x2 w; w.x = cvt_pk_bf16(v[q][0], v[q][1]); w.y = cvt_pk_bf16(v[q][2], v[q][3]); ((u32x2*)(P16 + (size_t)(r4 * 4 + q) * DPLE))[lane] = w; }
    }
    float* RT = (float*)(ws + WS_ROPE);
    for (int i = gt; i < 2049 * 32; i += NGT) { const int idx = i >> 5, fi = i & 31; const int pos = idx < SEQ ? idx : PAST;
        const float inv = (float)(ROPE_T8[fi & 7] * ROPE_P10[fi >> 3]); const float ang = (float)pos * inv;
        const double t = (double)ang * 0.15915494309189535; const float fr = (float)(t - rint(t));
        RT[2 * i] = __builtin_amdgcn_cosf(fr); RT[2 * i + 1] = __builtin_amdgcn_sinf(fr); }
    for (int i = gt; i < MS * 127 * 64; i += NGT) { const int b = i / (127 * 64), r = i % (127 * 64);
        ((f32x4*)(A.out + O_KS + (size_t)b * 128 * 256))[r] = ((const f32x4*)(A.in[I_CK] + (size_t)b * 128 * 256 + 256))[r];
        ((f32x4*)(A.out + O_VS + (size_t)b * 128 * 256))[r] = ((const f32x4*)(A.in[I_CV] + (size_t)b * 128 * 256 + 256))[r]; }
}

constexpr int SRS = 272;
constexpr int L_C = 0, L_B = 128 * SRS, L_BW = 2 * 128 * SRS, L_XT = 3 * 128 * SRS, L_HS = L_XT + 64 * SRS, L_CUM = L_HS + 64 * SRS, L_DTV = L_CUM + 512, L_SSD_END = L_DTV + 512;
static_assert(L_SSD_END <= LDS_BYTES, "ssd lds");
__device__ __forceinline__ float softplus_f(float x) { return x > 20.f ? x : log1pf(__expf(x)); }
__device__ __forceinline__ f32x16 mfma32(bf16x8 a, bf16x8 b, f32x16 c) { return __builtin_amdgcn_mfma_f32_32x32x16_bf16(a, b, c, 0, 0, 0); }
__device__ __forceinline__ void unpack8(u32x4 w, float (&f)[8]) { f[0] = bflo(w.x); f[1] = bfhi(w.x); f[2] = bflo(w.y); f[3] = bfhi(w.y); f[4] = bflo(w.z); f[5] = bfhi(w.z); f[6] = bflo(w.w); f[7] = bfhi(w.w); }

__device__ __forceinline__ void ssd_prompt_unit(const Args& A, LAS unsigned char* lds, int layer, int b, int h, int tid, int lane, int wid) {
    unsigned char* ws = A.ws;
    const bf16* XBC = (const bf16*)(ws + WS_XBC); const bf16* Z = (const bf16*)(ws + WS_Z); bf16* YG = (bf16*)(ws + WS_YG); const bf16* BCA = (const bf16*)(ws + WS_H);
    const float* DT = (const float*)(ws + WS_DT); float* GSQ = (float*)(ws + WS_GSQ);
    const int hi = lane >> 5, l32 = lane & 31, g = h >> 2;
    const float a_h = -__expf(A.in[I_SALOG][layer * NH + h]), dtb = A.in[I_SDTB][layer * NH + h], Dh = A.in[I_SD][layer * NH + h];
    LAS float* cum_s = (LAS float*)(lds + L_CUM); LAS float* dt_s = (LAS float*)(lds + L_DTV);
    f32x16 hacc;
#pragma unroll
    for (int r = 0; r < 16; ++r) hacc[r] = 0.f;
    for (int i = tid; i < 64 * SRS / 16; i += 512) *(LAS u32x4*)(lds + L_HS + i * 16) = (u32x4){0u, 0u, 0u, 0u};
    __syncthreads();
    float dtn = 0.f, dtn0 = 0.f;
    if (wid < 2) { dtn = DT[(size_t)(b * SEQ + tid) * 32 + h]; dtn0 = DT[(size_t)(b * SEQ + lane) * 32 + h]; }
    for (int c = 0; c < 16; ++c) {
        const int row0 = b * SEQ + c * 128;
        if (wid < 2) {
            const float dtv = softplus_f(dtn + dtb); float v = dtv * a_h;
#pragma unroll
            for (int o = 1; o < 64; o <<= 1) { const float t = __shfl_up(v, o); if (lane >= o) v += t; }
            if (wid == 1) { const float d0 = softplus_f(dtn0 + dtb) * a_h; v += wave_sum(d0); }
            cum_s[tid] = v; dt_s[tid] = dtv;
            if (c < 15) { dtn = DT[(size_t)(row0 + 128 + tid) * 32 + h]; dtn0 = DT[(size_t)(row0 + 128 + lane) * 32 + h]; }
        }
        __syncthreads();
        if (wid < 4) {
            const int oct = tid & 7, seg = tid >> 3, l0 = seg * 4, t0 = c * 128 + l0, chx = h * 64 + oct * 8;
            float cw[4][8], cb[8];
            {
                const float* cwp = A.in[I_SCW] + (size_t)layer * 4 * CONVD + chx; const float* cbp = A.in[I_SCB] + (size_t)layer * CONVD + chx;
#pragma unroll
                for (int k = 0; k < 4; ++k) { const f32x4 w0 = *(const f32x4*)(cwp + k * CONVD), w1 = *(const f32x4*)(cwp + k * CONVD + 4);
#pragma unroll
                    for (int e = 0; e < 4; ++e) { cw[k][e] = w0[e]; cw[k][4 + e] = w1[e]; } }
                const f32x4 b0 = *(const f32x4*)cbp, b1 = *(const f32x4*)(cbp + 4);
#pragma unroll
                for (int e = 0; e < 4; ++e) { cb[e] = b0[e]; cb[4 + e] = b1[e]; }
            }
            const bf16* src = XBC + (size_t)(b * SEQ + t0) * CONVD + chx;
            u32x4 rw[7];
#pragma unroll
            for (int j = 0; j < 7; ++j) { if (j < 3 && t0 < 3) rw[j] = (u32x4){0u, 0u, 0u, 0u}; else rw[j] = *(const u32x4*)(src + (j - 3) * CONVD); }
            float r0[8], r1[8], r2[8]; unpack8(rw[0], r0); unpack8(rw[1], r1); unpack8(rw[2], r2);
            unsigned tp[8][2];
#pragma unroll
            for (int i2 = 0; i2 < 2; ++i2) {
                float na[8], nb2[8]; unpack8(rw[3 + 2 * i2], na); unpack8(rw[4 + 2 * i2], nb2);
#pragma unroll
                for (int e = 0; e < 8; ++e) {
                    const float va = cb[e] + cw[0][e] * r0[e] + cw[1][e] * r1[e] + cw[2][e] * r2[e] + cw[3][e] * na[e];
                    const float vb = cb[e] + cw[0][e] * r1[e] + cw[1][e] * r2[e] + cw[2][e] * na[e] + cw[3][e] * nb2[e];
                    tp[e][i2] = cvt_pk_bf16(silu_f(va), silu_f(vb));
                    r0[e] = r2[e]; r1[e] = na[e]; r2[e] = nb2[e];
                }
            }
#pragma unroll
            for (int e = 0; e < 8; ++e) *(LAS u32x2*)(lds + L_XT + (oct * 8 + e) * SRS + l0 * 2) = (u32x2){tp[e][0], tp[e][1]};
        } else if (wid < 6) {
            const int t = tid - 256, oct = t & 15, l0 = (t >> 4) * 16; const float cl = cum_s[127];
            const bf16* src = BCA + (size_t)(row0 + l0) * 2048 + g * 128 + oct * 8;
#pragma unroll 2
            for (int hf = 0; hf < 4; ++hf) {
                u32x4 rw[4]; float f[4][8], sc[4];
#pragma unroll
                for (int j = 0; j < 4; ++j) rw[j] = *(const u32x4*)(src + (size_t)(4 * hf + j) * 2048);
#pragma unroll
                for (int j = 0; j < 4; ++j) { const int l = l0 + 4 * hf + j; *(LAS u32x4*)(lds + L_B + l * SRS + oct * 16) = rw[j]; unpack8(rw[j], f[j]); sc[j] = dt_s[l] * __expf(cl - cum_s[l]); }
#pragma unroll
                for (int e = 0; e < 8; ++e) *(LAS u32x2*)(lds + L_BW + (oct * 8 + e) * SRS + (l0 + 4 * hf) * 2) = (u32x2){cvt_pk_bf16(f[0][e] * sc[0], f[1][e] * sc[1]), cvt_pk_bf16(f[2][e] * sc[2], f[3][e] * sc[3])};
            }
        } else {
            const int t = tid - 384, oct = t & 15, l0 = (t >> 4) * 16;
            const bf16* src = BCA + (size_t)(row0 + l0) * 2048 + 1024 + g * 128 + oct * 8;
#pragma unroll 8
            for (int j = 0; j < 16; ++j) *(LAS u32x4*)(lds + L_C + (l0 + j) * SRS + oct * 16) = *(const u32x4*)(src + (size_t)j * 2048);
        }
        __syncthreads();
        u32x2 zpre[4];
        {
            const int pb = wid & 1, lb = wid >> 1; const size_t zrow = (size_t)row0 + 32 * lb + l32;
#pragma unroll
            for (int rq = 0; rq < 4; ++rq) zpre[rq] = *(const u32x2*)(Z + zrow * DIN + h * 64 + 32 * pb + 8 * rq + 4 * hi);
        }
        {
            const int lb = wid >> 1;
            f32x16 cacc[2];
#pragma unroll
            for (int t = 0; t < 2; ++t) {
#pragma unroll
                for (int r = 0; r < 16; ++r) cacc[t][r] = 0.f;
                const int sb = 2 * (wid & 1) + t;
                if (sb <= lb) {
#pragma unroll
                    for (int ks = 0; ks < 8; ++ks) {
                        const bf16x8 av = *(const LAS bf16x8*)(lds + L_B + (32 * sb + l32) * SRS + (16 * ks + 8 * hi) * 2);
                        const bf16x8 bv = *(const LAS bf16x8*)(lds + L_C + (32 * lb + l32) * SRS + (16 * ks + 8 * hi) * 2);
                        cacc[t] = mfma32(av, bv, cacc[t]);
                    }
                }
            }
            __syncthreads();
            const int l = 32 * lb + l32; const float cll = cum_s[l];
#pragma unroll
            for (int t = 0; t < 2; ++t) {
                const int sb = 2 * (wid & 1) + t;
                if (sb <= lb) {
#pragma unroll
                    for (int rq = 0; rq < 4; ++rq) {
                        const int s0 = 32 * sb + 8 * rq + 4 * hi; float v[4];
#pragma unroll
                        for (int e = 0; e < 4; ++e) { const int s = s0 + e; float x = cacc[t][4 * rq + e] * __expf(cll - cum_s[s]) * dt_s[s]; x = (s > l) ? 0.f : x; x = (s == l) ? x + Dh : x; v[e] = x; }
                        u32x2 w; w.x = cvt_pk_bf16(v[0], v[1]); w.y = cvt_pk_bf16(v[2], v[3]);
                        *(LAS u32x2*)(lds + L_B + l * SRS + s0 * 2) = w;
                    }
                }
            }
        }
        __syncthreads();
        {
            const int pb = wid & 1, lb = wid >> 1;
            f32x16 yacc;
#pragma unroll
            for (int r = 0; r < 16; ++r) yacc[r] = 0.f;
#pragma unroll
            for (int ks = 0; ks < 8; ++ks) {
                const bf16x8 av = *(const LAS bf16x8*)(lds + L_HS + (32 * pb + l32) * SRS + (16 * ks + 8 * hi) * 2);
                const bf16x8 bv = *(const LAS bf16x8*)(lds + L_C + (32 * lb + l32) * SRS + (16 * ks + 8 * hi) * 2);
                yacc = mfma32(av, bv, yacc);
            }
            const float el = __expf(cum_s[32 * lb + l32]);
#pragma unroll
            for (int r = 0; r < 16; ++r) yacc[r] *= el;
            for (int sb = 0; sb <= lb; ++sb) {
#pragma unroll
                for (int k2 = 0; k2 < 2; ++k2) {
                    const bf16x8 av = *(const LAS bf16x8*)(lds + L_XT + (32 * pb + l32) * SRS + (32 * sb + 16 * k2 + 8 * hi) * 2);
                    const bf16x8 bv = *(const LAS bf16x8*)(lds + L_B + (32 * lb + l32) * SRS + (32 * sb + 16 * k2 + 8 * hi) * 2);
                    yacc = mfma32(av, bv, yacc);
                }
            }
            const size_t row = (size_t)row0 + 32 * lb + l32; float sq = 0.f;
#pragma unroll
            for (int rq = 0; rq < 4; ++rq) {
                const int p0 = 32 * pb + 8 * rq + 4 * hi; const u32x2 zz = zpre[rq];
                const float g0 = yacc[4 * rq + 0] * silu_f(bflo(zz.x)), g1 = yacc[4 * rq + 1] * silu_f(bfhi(zz.x)), g2 = yacc[4 * rq + 2] * silu_f(bflo(zz.y)), g3 = yacc[4 * rq + 3] * silu_f(bfhi(zz.y));
                sq += (g0 * g0 + g1 * g1) + (g2 * g2 + g3 * g3);
                u32x2 w; w.x = cvt_pk_bf16(g0, g1); w.y = cvt_pk_bf16(g2, g3); *(u32x2*)(YG + row * DIN + h * 64 + p0) = w;
            }
            sq += __shfl_xor(sq, 32);
            if (hi == 0) GSQ[row * 64 + 2 * h + pb] = sq;
        }
        const int nb = wid & 3, pb2 = wid >> 2;
        {
            const float dl = __expf(cum_s[127]);
#pragma unroll
            for (int r = 0; r < 16; ++r) hacc[r] *= dl;
#pragma unroll
            for (int ks = 0; ks < 8; ++ks) {
                const bf16x8 av = *(const LAS bf16x8*)(lds + L_BW + (32 * nb + l32) * SRS + (16 * ks + 8 * hi) * 2);
                const bf16x8 bv = *(const LAS bf16x8*)(lds + L_XT + (32 * pb2 + l32) * SRS + (16 * ks + 8 * hi) * 2);
                hacc = mfma32(av, bv, hacc);
            }
        }
        __syncthreads();
        {
            const int p = 32 * pb2 + l32;
#pragma unroll
            for (int rq = 0; rq < 4; ++rq) { const int n0 = 32 * nb + 8 * rq + 4 * hi; u32x2 w; w.x = cvt_pk_bf16(hacc[4 * rq], hacc[4 * rq + 1]); w.y = cvt_pk_bf16(hacc[4 * rq + 2], hacc[4 * rq + 3]);
                *(LAS u32x2*)(lds + L_HS + p * SRS + n0 * 2) = w; }
        }
    }
    int lane2 = lane; asm volatile("" : "+v"(lane2));
    {
        const int hi = lane2 >> 5, l32 = lane2 & 31;
        const int nb = wid & 3, pb2 = wid >> 2, p = 32 * pb2 + l32;
        float* o = A.out + O_SSMP + (((size_t)(layer * NB + b) * NH + h) * 64 + p) * DST;
#pragma unroll
        for (int rq = 0; rq < 4; ++rq) { const int n0 = 32 * nb + 8 * rq + 4 * hi; *(f32x4*)(o + n0) = (f32x4){hacc[4 * rq], hacc[4 * rq + 1], hacc[4 * rq + 2], hacc[4 * rq + 3]}; }
    }
    const int tid2 = wid * 64 + lane2;
    if (tid2 < 384) { const int k = tid2 >> 7, j = tid2 & 127, chn = h * 128 + j;
        A.out[O_CONVP + ((size_t)(layer * NB + b) * 3 + k) * CONVD + chn] = bf1(XBC[(size_t)(b * SEQ + SEQ - 3 + k) * CONVD + chn]); }
    __syncthreads();
}

__device__ __forceinline__ void ssd_sample_item(const Args& A, int layer, int b, int h, int lane) {
    unsigned char* ws = A.ws;
    const bf16* XBC = (const bf16*)(ws + WS_XBC); const bf16* Z = (const bf16*)(ws + WS_Z); bf16* YG = (bf16*)(ws + WS_YG);
    const float* DT = (const float*)(ws + WS_DT); float* GSQ = (float*)(ws + WS_GSQ);
    const int g = h >> 2, psub = lane >> 4, nch = lane & 15, n0 = 8 * nch; const size_t row = (size_t)MP + b;
    const float* cwp = A.in[I_SCW] + (size_t)layer * 4 * CONVD; const float* cbp = A.in[I_SCB] + (size_t)layer * CONVD;
    const float* c0 = A.in[I_CONV] + ((size_t)layer * MS + b) * 3 * CONVD;
    float Bv[8], Cv[8];
    {
        const int chB = DIN + g * 128 + n0, chC = DIN + 1024 + g * 128 + n0;
        float nB[8], nC[8]; unpack8(*(const u32x4*)(XBC + row * CONVD + chB), nB); unpack8(*(const u32x4*)(XBC + row * CONVD + chC), nC);
#pragma unroll
        for (int e = 0; e < 8; ++e) {
            float vb = cbp[chB + e] + cwp[3 * CONVD + chB + e] * nB[e], vc = cbp[chC + e] + cwp[3 * CONVD + chC + e] * nC[e];
#pragma unroll
            for (int k = 0; k < 3; ++k) { vb += cwp[k * CONVD + chB + e] * c0[k * CONVD + chB + e]; vc += cwp[k * CONVD + chC + e] * c0[k * CONVD + chC + e]; }
            Bv[e] = silu_f(vb); Cv[e] = silu_f(vc);
        }
    }
    float xact;
    { const int chx = h * 64 + lane; float v = cbp[chx] + cwp[3 * CONVD + chx] * bf1(XBC[row * CONVD + chx]);
#pragma unroll
      for (int k = 0; k < 3; ++k) v += cwp[k * CONVD + chx] * c0[k * CONVD + chx];
      xact = silu_f(v); }
    const float a_h = -__expf(A.in[I_SALOG][layer * NH + h]), Dh = A.in[I_SD][layer * NH + h];
    const float dtv = softplus_f(DT[row * 32 + h] + A.in[I_SDTB][layer * NH + h]); const float dec = __expf(dtv * a_h);
    const float* h0 = A.in[I_SSM] + (((size_t)layer * MS + b) * NH + h) * 64 * DST; float* h1 = A.out + O_SSMS + (((size_t)layer * MS + b) * NH + h) * 64 * DST;
    float sq = 0.f;
#pragma unroll 4
    for (int it = 0; it < 16; ++it) {
        const int p = 4 * it + psub; const float xp = __shfl(xact, p); const float xd = xp * dtv;
        const f32x4 a0 = *(const f32x4*)(h0 + p * DST + n0), a1 = *(const f32x4*)(h0 + p * DST + n0 + 4);
        f32x4 o0, o1; float yp = 0.f;
#pragma unroll
        for (int e = 0; e < 4; ++e) { o0[e] = dec * a0[e] + xd * Bv[e]; o1[e] = dec * a1[e] + xd * Bv[4 + e]; yp += o0[e] * Cv[e] + o1[e] * Cv[4 + e]; }
        *(f32x4*)(h1 + p * DST + n0) = o0; *(f32x4*)(h1 + p * DST + n0 + 4) = o1;
        yp += __shfl_xor(yp, 1); yp += __shfl_xor(yp, 2); yp += __shfl_xor(yp, 4); yp += __shfl_xor(yp, 8);
        if (nch == 0) { const float y = yp + Dh * xp; const float gt = y * silu_f(bf1(Z[row * DIN + h * 64 + p])); sq += gt * gt; YG[row * DIN + h * 64 + p] = f2bf(gt); }
    }
    sq += __shfl_xor(sq, 16); sq += __shfl_xor(sq, 32);
    if (lane == 0) { GSQ[row * 64 + 2 * h] = sq; GSQ[row * 64 + 2 * h + 1] = 0.f; }
}

__device__ __forceinline__ void ssd_pre_phase(const Args& A, int layer, int tid, int lane, int wid) {
    const bf16* XBC = (const bf16*)(A.ws + WS_XBC); bf16* BCA = (bf16*)(A.ws + WS_H);
    for (int task = blockIdx.x * 512 + tid; task < 256 * (MP / 32); task += gridDim.x * 512) {
        const int oct = task & 255, m0 = (task >> 8) * 32, t0 = m0 % SEQ, chn = DIN + oct * 8;
        float cw[4][8], cb[8];
        {
            const float* cwp = A.in[I_SCW] + (size_t)layer * 4 * CONVD + chn; const float* cbp = A.in[I_SCB] + (size_t)layer * CONVD + chn;
#pragma unroll
            for (int k = 0; k < 4; ++k) { const f32x4 w0 = *(const f32x4*)(cwp + k * CONVD), w1 = *(const f32x4*)(cwp + k * CONVD + 4);
#pragma unroll
                for (int e = 0; e < 4; ++e) { cw[k][e] = w0[e]; cw[k][4 + e] = w1[e]; } }
            const f32x4 b0 = *(const f32x4*)cbp, b1 = *(const f32x4*)(cbp + 4);
#pragma unroll
            for (int e = 0; e < 4; ++e) { cb[e] = b0[e]; cb[4 + e] = b1[e]; }
        }
        const bf16* src = XBC + (size_t)m0 * CONVD + chn; bf16* dst = BCA + (size_t)m0 * 2048 + oct * 8;
        float r0[8], r1[8], r2[8];
        if (t0 >= 3) { unpack8(*(const u32x4*)(src - 3 * CONVD), r0); unpack8(*(const u32x4*)(src - 2 * CONVD), r1); unpack8(*(const u32x4*)(src - 1 * CONVD), r2); }
        else {
#pragma unroll
            for (int e = 0; e < 8; ++e) { r0[e] = 0.f; r1[e] = 0.f; r2[e] = 0.f; }
        }
#pragma unroll 1
        for (int i8 = 0; i8 < 4; ++i8) {
            u32x4 rw[8];
#pragma unroll
            for (int j = 0; j < 8; ++j) rw[j] = *(const u32x4*)(src + (size_t)(8 * i8 + j) * CONVD);
#pragma unroll
            for (int j = 0; j < 8; ++j) {
                float na[8], aa[8]; unpack8(rw[j], na);
#pragma unroll
                for (int e = 0; e < 8; ++e) { aa[e] = silu_f(cb[e] + cw[0][e] * r0[e] + cw[1][e] * r1[e] + cw[2][e] * r2[e] + cw[3][e] * na[e]); r0[e] = r1[e]; r1[e] = r2[e]; r2[e] = na[e]; }
                u32x4 w; w.x = cvt_pk_bf16(aa[0], aa[1]); w.y = cvt_pk_bf16(aa[2], aa[3]); w.z = cvt_pk_bf16(aa[4], aa[5]); w.w = cvt_pk_bf16(aa[6], aa[7]);
                *(u32x4*)(dst + (size_t)(8 * i8 + j) * 2048) = w;
            }
        }
    }
    for (int it = blockIdx.x * 8 + wid; it < MS * NH; it += gridDim.x * 8) ssd_sample_item(A, layer, it / NH, it % NH, lane);
    for (int i = blockIdx.x * 512 + tid; i < MS * 3 * CONVD; i += gridDim.x * 512) { const int b = i / (3 * CONVD), r = i % (3 * CONVD), k = r / CONVD, chn = r % CONVD;
        A.out[O_CONVS + (size_t)layer * MS * 3 * CONVD + i] = (k < 2) ? A.in[I_CONV][((size_t)layer * MS + b) * 3 * CONVD + (k + 1) * CONVD + chn] : bf1(XBC[(size_t)(MP + b) * CONVD + chn]); }
}
__device__ __forceinline__ void ssd_phase(const Args& A, LAS unsigned char* lds, int layer, int tid, int lane, int wid) {
    for (int u = blockIdx.x; u < NB * NH; u += gridDim.x) ssd_prompt_unit(A, lds, layer, u / NH, u % NH, tid, lane, wid);
}
__device__ __forceinline__ void gnorm_phase(const Args& A, int tid) {
    bf16* YG = (bf16*)(A.ws + WS_YG); const float* GSQ = (const float*)(A.ws + WS_GSQ);
    for (int i = blockIdx.x * 512 + tid; i < MR * 256; i += gridDim.x * 512) { const int m = i >> 8, c8 = i & 255, g = c8 >> 5;
        const f32x4 s0 = *(const f32x4*)(GSQ + (size_t)m * 64 + g * 8), s1 = *(const f32x4*)(GSQ + (size_t)m * 64 + g * 8 + 4);
        const float s = ((s0[0] + s0[1]) + (s0[2] + s0[3])) + ((s1[0] + s1[1]) + (s1[2] + s1[3])); const float rs = __builtin_amdgcn_rsqf(s * (1.0f / 256.0f) + 1e-6f);
        u32x4* p = (u32x4*)(YG + (size_t)m * DIN + c8 * 8); const u32x4 w = *p; float f[8]; unpack8(w, f);
        u32x4 o; o.x = cvt_pk_bf16(f[0] * rs, f[1] * rs); o.y = cvt_pk_bf16(f[2] * rs, f[3] * rs); o.z = cvt_pk_bf16(f[4] * rs, f[5] * rs); o.w = cvt_pk_bf16(f[6] * rs, f[7] * rs); *p = o; }
}

__device__ __forceinline__ void kv_finalize(const Args& A, int lane, int wid) {
    unsigned char* ws = A.ws; const float* KV = (const float*)(ws + WS_KVRAW); const float* RT = (const float*)(ws + WS_ROPE);
    bf16* KF = (bf16*)(ws + WS_KF); bf16* VT = (bf16*)(ws + WS_VT);
    const int kvh = lane >> 4, j = lane & 15;
    const float gn0 = A.in[I_KN][2 * j], gn1 = A.in[I_KN][2 * j + 1], gn2 = A.in[I_KN][2 * j + 32], gn3 = A.in[I_KN][2 * j + 33];
    for (int m = blockIdx.x * 8 + wid; m < MR; m += gridDim.x * 8) {
        const float* kr = KV + (size_t)m * 512 + kvh * 64; const float* vr = kr + 256;
        float x10 = kr[2 * j], x11 = kr[2 * j + 1], x20 = kr[2 * j + 32], x21 = kr[2 * j + 33];
        float ss = (x10 * x10 + x11 * x11) + (x20 * x20 + x21 * x21);
        ss += __shfl_xor(ss, 1); ss += __shfl_xor(ss, 2); ss += __shfl_xor(ss, 4); ss += __shfl_xor(ss, 8);
        const float rs = __builtin_amdgcn_rsqf(ss * (1.0f / 64.0f) + 1e-6f);
        x10 *= rs * gn0; x11 *= rs * gn1; x20 *= rs * gn2; x21 *= rs * gn3;
        const int pidx = m < MP ? (m % SEQ) : SEQ;
        const f32x4 cs = *(const f32x4*)(RT + ((size_t)pidx * 32 + 2 * j) * 2);
        const float o10 = x10 * cs[0] - x20 * cs[1], o20 = x20 * cs[0] + x10 * cs[1], o11 = x11 * cs[2] - x21 * cs[3], o21 = x21 * cs[2] + x11 * cs[3];
        const f32x4 v4 = *(const f32x4*)(vr + 4 * j);
        if (m < MP) {
            const int b = m / SEQ, t = m % SEQ; const size_t bk = (size_t)b * 4 + kvh;
            bf16* kd = KF + (bk * SEQ + t) * 64;
            *(unsigned*)(kd + 2 * j) = cvt_pk_bf16(o10, o11); *(unsigned*)(kd + 2 * j + 32) = cvt_pk_bf16(o20, o21);
            bf16* vd = VT + ((bk * 64 + (t >> 5)) * 64 + 4 * j) * 32 + (t & 31);
            vd[0] = f2bf(v4[0]); vd[32] = f2bf(v4[1]); vd[64] = f2bf(v4[2]); vd[96] = f2bf(v4[3]);
            if (t >= SEQ - 128) { float* ko = A.out + O_KP + (((size_t)b * 128 + (t - (SEQ - 128))) * 4 + kvh) * 64; float* vo = A.out + O_VP + (((size_t)b * 128 + (t - (SEQ - 128))) * 4 + kvh) * 64;
                ko[2 * j] = o10; ko[2 * j + 1] = o11; ko[2 * j + 32] = o20; ko[2 * j + 33] = o21; *(f32x4*)(vo + 4 * j) = v4; }
        } else {
            const int b = m - MP; float* ko = A.out + O_KS + (((size_t)b * 128 + 127) * 4 + kvh) * 64; float* vo = A.out + O_VS + (((size_t)b * 128 + 127) * 4 + kvh) * 64;
            ko[2 * j] = o10; ko[2 * j + 1] = o11; ko[2 * j + 32] = o20; ko[2 * j + 33] = o21; *(f32x4*)(vo + 4 * j) = v4;
        }
    }
}

constexpr int KRS = 144, VRS = 80, L_AK = 0, L_AV = 256 * KRS;
__device__ __forceinline__ void attn_prompt_tile(const Args& A, LAS unsigned char* lds, int lt0, int jl, int b, int hq, int r0, int lane) {
    unsigned char* ws = A.ws; const bf16* Q = (const bf16*)(ws + WS_Q); bf16* O = (bf16*)(ws + WS_O); const float* RT = (const float*)(ws + WS_ROPE);
    const bf16* KF = (const bf16*)(ws + WS_KF); const bf16* VT = (const bf16*)(ws + WS_VT);
    const int hi = lane >> 5, l32 = lane & 31, kvh = hq >> 2; const size_t bk = (size_t)b * 4 + kvh;
    const int qp = r0 + l32; const size_t qrow = (size_t)b * SEQ + qp;
    bf16x8 qf[4];
    {
        float qv[4][8]; float ss = 0.f;
#pragma unroll
        for (int ks = 0; ks < 4; ++ks) { unpack8(*(const u32x4*)(Q + qrow * DM + hq * 64 + 16 * ks + 8 * hi), qv[ks]);
#pragma unroll
            for (int e = 0; e < 8; ++e) ss += qv[ks][e] * qv[ks][e]; }
        ss += __shfl_xor(ss, 32);
        const float rs = __builtin_amdgcn_rsqf(ss * (1.0f / 64.0f) + 1e-6f) * 0.125f;
        const float* qn = A.in[I_QN] + jl * 64;
#pragma unroll
        for (int ks = 0; ks < 2; ++ks) {
            float o1[8], o2[8];
#pragma unroll
            for (int e = 0; e < 8; ++e) { const int i = 16 * ks + 8 * hi + e; const float x1 = qv[ks][e] * rs * qn[i], x2 = qv[ks + 2][e] * rs * qn[i + 32];
                const float cs = RT[((size_t)qp * 32 + i) * 2], sn = RT[((size_t)qp * 32 + i) * 2 + 1]; o1[e] = x1 * cs - x2 * sn; o2[e] = x2 * cs + x1 * sn; }
            u32x4 w; w.x = cvt_pk_bf16(o1[0], o1[1]); w.y = cvt_pk_bf16(o1[2], o1[3]); w.z = cvt_pk_bf16(o1[4], o1[5]); w.w = cvt_pk_bf16(o1[6], o1[7]); qf[ks] = __builtin_bit_cast(bf16x8, w);
            w.x = cvt_pk_bf16(o2[0], o2[1]); w.y = cvt_pk_bf16(o2[2], o2[3]); w.z = cvt_pk_bf16(o2[4], o2[5]); w.w = cvt_pk_bf16(o2[6], o2[7]); qf[ks + 2] = __builtin_bit_cast(bf16x8, w);
        }
    }
    f32x16 s[5];
    const float NEG = -1e30f;
#pragma unroll
    for (int kt = 0; kt < 5; ++kt) {
        const int k0 = r0 - 128 + 32 * kt;
#pragma unroll
        for (int r = 0; r < 16; ++r) s[kt][r] = 0.f;
        if (k0 >= 0) {
#pragma unroll
            for (int ks = 0; ks < 4; ++ks) { const bf16x8 kf = *(const LAS bf16x8*)(lds + L_AK + (32 * (lt0 + kt) + l32) * KRS + (16 * ks + 8 * hi) * 2); s[kt] = mfma32(kf, qf[ks], s[kt]); }
        }
    }
    const float sink = A.in[I_SINK][jl * 16 + hq];
    float mx = sink;
#pragma unroll
    for (int kt = 0; kt < 5; ++kt) {
        const int k0 = r0 - 128 + 32 * kt;
#pragma unroll
        for (int r = 0; r < 16; ++r) { const int kp = k0 + (r & 3) + 8 * (r >> 2) + 4 * hi; const bool ok = (kp >= 0) && (kp <= qp) && (qp - kp <= 128);
            s[kt][r] = ok ? s[kt][r] : NEG; mx = fmaxf(mx, s[kt][r]); }
    }
    mx = fmaxf(mx, __shfl_xor(mx, 32));
    float sum = 0.f;
#pragma unroll
    for (int kt = 0; kt < 5; ++kt)
#pragma unroll
        for (int r = 0; r < 16; ++r) { const float p = __expf(s[kt][r] - mx); s[kt][r] = p; sum += p; }
    sum += __shfl_xor(sum, 32);
    sum += __expf(sink - mx);
    f32x16 oacc[2];
#pragma unroll
    for (int dt = 0; dt < 2; ++dt)
#pragma unroll
        for (int r = 0; r < 16; ++r) oacc[dt][r] = 0.f;
#pragma unroll
    for (int kt = 0; kt < 5; ++kt) {
        const int k0 = r0 - 128 + 32 * kt;
        if (k0 >= 0) {
#pragma unroll
            for (int k2 = 0; k2 < 2; ++k2) {
                u32x4 pw; pw.x = cvt_pk_bf16(s[kt][8 * k2], s[kt][8 * k2 + 1]); pw.y = cvt_pk_bf16(s[kt][8 * k2 + 2], s[kt][8 * k2 + 3]); pw.z = cvt_pk_bf16(s[kt][8 * k2 + 4], s[kt][8 * k2 + 5]); pw.w = cvt_pk_bf16(s[kt][8 * k2 + 6], s[kt][8 * k2 + 7]);
                const bf16x8 pf = __builtin_bit_cast(bf16x8, pw);
#pragma unroll
                for (int dt = 0; dt < 2; ++dt) {
                    const LAS unsigned char* vp = lds + L_AV + ((lt0 + kt) * 64 + 32 * dt + l32) * VRS + (16 * k2 + 4 * hi) * 2;
                    const u32x2 v0 = *(const LAS u32x2*)vp, v1 = *(const LAS u32x2*)(vp + 16);
                    const bf16x8 vf = __builtin_bit_cast(bf16x8, ((u32x4){v0.x, v0.y, v1.x, v1.y}));
                    oacc[dt] = mfma32(vf, pf, oacc[dt]);
                }
            }
        }
    }
    const float inv = __builtin_amdgcn_rcpf(sum);
#pragma unroll
    for (int dt = 0; dt < 2; ++dt)
#pragma unroll
        for (int rq = 0; rq < 4; ++rq) { const int d0 = 32 * dt + 8 * rq + 4 * hi; u32x2 w; w.x = cvt_pk_bf16(oacc[dt][4 * rq] * inv, oacc[dt][4 * rq + 1] * inv); w.y = cvt_pk_bf16(oacc[dt][4 * rq + 2] * inv, oacc[dt][4 * rq + 3] * inv);
            *(u32x2*)(O + qrow * DM + hq * 64 + d0) = w; }
}
__device__ __forceinline__ void attn_sample_item(const Args& A, int jl, int b, int hq, int lane) {
    unsigned char* ws = A.ws; const bf16* Q = (const bf16*)(ws + WS_Q); bf16* O = (bf16*)(ws + WS_O); const float* RT = (const float*)(ws + WS_ROPE);
    const int kvh = hq >> 2; const size_t row = (size_t)MP + b;
    float qv = bf1(Q[row * DM + hq * 64 + lane]);
    const float ss = wave_sum(qv * qv); qv *= __builtin_amdgcn_rsqf(ss * (1.0f / 64.0f) + 1e-6f) * A.in[I_QN][jl * 64 + lane];
    const float other = __shfl_xor(qv, 32); const int i32 = lane & 31; const float cs = RT[((size_t)SEQ * 32 + i32) * 2], sn = RT[((size_t)SEQ * 32 + i32) * 2 + 1];
    const float qr = ((lane < 32) ? (qv * cs - other * sn) : (qv * cs + other * sn)) * 0.125f;
    const int dq = lane & 15, kg = lane >> 4;
    f32x4 q4;
#pragma unroll
    for (int e = 0; e < 4; ++e) q4[e] = __shfl(qr, 4 * dq + e);
    const float* ck = A.in[I_CK] + (size_t)b * 128 * 256 + kvh * 64 + 4 * dq; const float* kn = A.out + O_KS + ((size_t)b * 128 + 127) * 256 + kvh * 64 + 4 * dq;
    const float* cv = A.in[I_CV] + (size_t)b * 128 * 256 + kvh * 64 + 4 * dq; const float* vn = A.out + O_VS + ((size_t)b * 128 + 127) * 256 + kvh * 64 + 4 * dq;
    float sc[33];
#pragma unroll
    for (int i = 0; i < 33; ++i) { const int j = 4 * i + kg; float a = 0.f;
        if (j <= 128) { const f32x4 k4 = *(const f32x4*)((j < 128) ? ck + (size_t)j * 256 : kn); a = (k4[0] * q4[0] + k4[1] * q4[1]) + (k4[2] * q4[2] + k4[3] * q4[3]); }
        sc[i] = a;
        if (i % 11 == 10) asm volatile("" ::: "memory"); }
    const float sink = A.in[I_SINK][jl * 16 + hq];
    float mx = sink;
#pragma unroll
    for (int i = 0; i < 33; ++i) { float a = sc[i]; a += __shfl_xor(a, 1); a += __shfl_xor(a, 2); a += __shfl_xor(a, 4); a += __shfl_xor(a, 8);
        a = (4 * i + kg <= 128) ? a : -1e30f; sc[i] = a; mx = fmaxf(mx, a); }
    mx = fmaxf(mx, __shfl_xor(mx, 16)); mx = fmaxf(mx, __shfl_xor(mx, 32));
    float sum = 0.f;
#pragma unroll
    for (int i = 0; i < 33; ++i) { const float p = __expf(sc[i] - mx); sc[i] = p; sum += p; }
    sum += __shfl_xor(sum, 16); sum += __shfl_xor(sum, 32);
    sum += __expf(sink - mx);
    f32x4 o4 = (f32x4){0.f, 0.f, 0.f, 0.f};
#pragma unroll
    for (int i = 0; i < 33; ++i) { const int j = 4 * i + kg;
        if (j <= 128) { const f32x4 v4 = *(const f32x4*)((j < 128) ? cv + (size_t)j * 256 : vn); o4 += v4 * sc[i]; }
        if (i % 11 == 10) asm volatile("" ::: "memory"); }
#pragma unroll
    for (int e = 0; e < 4; ++e) { o4[e] += __shfl_xor(o4[e], 16); o4[e] += __shfl_xor(o4[e], 32); }
    const float inv = __builtin_amdgcn_rcpf(sum);
    if (kg == 0) { u32x2 w; w.x = cvt_pk_bf16(o4[0] * inv, o4[1] * inv); w.y = cvt_pk_bf16(o4[2] * inv, o4[3] * inv); *(u32x2*)(O + row * DM + hq * 64 + 4 * dq) = w; }
}
__device__ __forceinline__ void attn_phase(const Args& A, LAS unsigned char* lds, int jl, int tid, int lane, int wid) {
    const bf16* KFg = (const bf16*)(A.ws + WS_KF); const bf16* VTg = (const bf16*)(A.ws + WS_VT);
    for (int u = blockIdx.x; u < NB * 16 * 4; u += gridDim.x) { const int kvh = u & 3, qb = (u >> 2) & 15, b = u >> 6;
        const size_t bk = (size_t)b * 4 + kvh; const int q0 = qb * 128;
        __syncthreads();
#pragma unroll
        for (int j = 0; j < 4; ++j) { const int ci = tid + 512 * j, row = ci >> 3, part = ci & 7, t = q0 - 128 + row;
            if (t >= 0) *(LAS u32x4*)(lds + L_AK + row * KRS + part * 16) = *(const u32x4*)(KFg + (bk * SEQ + t) * 64 + part * 8); }
#pragma unroll
        for (int j = 0; j < 4; ++j) { const int ci = tid + 512 * j, row = ci >> 2, part = ci & 3, tile = (q0 - 128) / 32 + (row >> 6);
            if (tile >= 0) *(LAS u32x4*)(lds + L_AV + row * VRS + part * 16) = *(const u32x4*)(VTg + ((bk * 64 + tile) * 64 + (row & 63)) * 32 + part * 8); }
        __syncthreads();
        const int hq = kvh * 4 + (wid >> 1), r0 = q0 + (wid & 1) * 64, lt0 = 2 * (wid & 1);
        attn_prompt_tile(A, lds, lt0, jl, b, hq, r0, lane); attn_prompt_tile(A, lds, lt0 + 1, jl, b, hq, r0 + 32, lane); }
    __syncthreads();
    for (int it = blockIdx.x * 8 + wid; it < MS * 16; it += gridDim.x * 8) attn_sample_item(A, jl, it >> 4, it & 15, lane);
}

struct Thin { const bf16* A; const bf16* Wt; int K; int mode; const bf16* XBi; float* Xout; bf16* XBo; float* SSout; const float* SSin; bf16* PP; bf16* Q; float scale; };
typedef float f32x2v __attribute__((ext_vector_type(2)));
__device__ __forceinline__ void thin_gemm(LAS unsigned char* lds, const Thin& T, int tid, int lane, int wid, int bid) {
    if (bid >= 128) return;
    const int rt = bid >> 4, ct = bid & 15, fr = lane & 15, fq = lane >> 4;
    const int kw = T.K >> 3, k0 = wid * kw;
    const bf16* ap = T.A + (size_t)(MP + rt * 16 + fr) * T.K + k0 + 8 * fq;
    const bf16* bp = T.Wt + (size_t)(ct * 64 + fr) * T.K + k0 + 8 * fq;
    f32x4 acc[4];
#pragma unroll
    for (int c = 0; c < 4; ++c) acc[c] = (f32x4){0.f, 0.f, 0.f, 0.f};
#pragma unroll 2
    for (int k = 0; k < kw; k += 32) {
        const bf16x8 av = *(const bf16x8*)(ap + k);
#pragma unroll
        for (int c = 0; c < 4; ++c) { const bf16x8 bv = *(const bf16x8*)(bp + (size_t)c * 16 * T.K + k); acc[c] = __builtin_amdgcn_mfma_f32_16x16x32_bf16(av, bv, acc[c], 0, 0, 0); }
    }
    LAS float* red = (LAS float*)lds;
#pragma unroll
    for (int c = 0; c < 4; ++c)
#pragma unroll
        for (int r = 0; r < 4; ++r) red[(wid * 16 + 4 * fq + r) * 64 + c * 16 + fr] = acc[c][r];
    __syncthreads();
    const int row_l = tid >> 5, c2 = (tid & 31) * 2;
    f32x2v v = (f32x2v){0.f, 0.f};
#pragma unroll
    for (int w = 0; w < 8; ++w) v += *(const LAS f32x2v*)(red + (w * 16 + row_l) * 64 + c2);
    const int row = MP + rt * 16 + row_l, col = ct * 64 + c2; const size_t off = (size_t)row * DM + col;
    if (T.mode <= 1) {
        const unsigned xw = *(const unsigned*)(T.XBi + off); f32x2v x = (f32x2v){bflo(xw), bfhi(xw)};
        if (T.mode == 1) { const float rs = pg8::rstd_row(T.SSin, row); const unsigned pw = *(const unsigned*)(T.PP + off); x[0] += pg8::sigmoid_f(v[0] * rs) * bflo(pw); x[1] += pg8::sigmoid_f(v[1] * rs) * bfhi(pw); }
        else x += v * T.scale;
        float ssq = x[0] * x[0] + x[1] * x[1];
        if (T.Xout) *(f32x2v*)(T.Xout + off) = x;
        *(unsigned*)(T.XBo + off) = cvt_pk_bf16(x[0], x[1]);
        ssq += __shfl_xor(ssq, 1); ssq += __shfl_xor(ssq, 2); ssq += __shfl_xor(ssq, 4); ssq += __shfl_xor(ssq, 8); ssq += __shfl_xor(ssq, 16);
        if ((tid & 31) == 0) T.SSout[(size_t)row * 16 + ct] = ssq;
    } else if (T.mode == 2) { const float rs = pg8::rstd_row(T.SSin, row); *(unsigned*)(T.Q + off) = cvt_pk_bf16(v[0] * rs, v[1] * rs); }
    else *(unsigned*)(T.PP + off) = cvt_pk_bf16(v[0], v[1]);
    __syncthreads();
}

#define GEMM_RUN(EPI, g, E) do { pg8::StaticOrder S_; S_.init((g).M, (g).N, (int)gridDim.x, bid); pg8::gemm_phase<EPI, pg8::StaticOrder, true, true>(lds, (g), S_, (E), tid); } while (0)

__global__ void __launch_bounds__(512, 2) yoco_fwd(Args A_) {
    extern __shared__ __attribute__((aligned(16))) unsigned char lds_raw[];
    LAS unsigned char* lds = (LAS unsigned char*)lds_raw;
    const int wid = __builtin_amdgcn_readfirstlane((int)threadIdx.x >> 6);
    typedef const __attribute__((address_space(4))) Args* CArgsP;
    const int ph_lo = A_.ph_lo, ph_hi = A_.ph_hi;
    volatile LAS unsigned* MISC = (volatile LAS unsigned*)(lds + LDS_BYTES - 64);
    XcdBarrier gbar; gbar.bar = (unsigned*)(A_.ws + WS_BAR); gbar.x = 0; gbar.st = MISC;
    if (ph_hi - ph_lo > 1) {
        const int tid0 = (int)threadIdx.x;
        if (tid0 < 16) MISC[tid0] = 0u;
        __syncthreads();
        gbar = xcd_barrier_post((unsigned*)(A_.ws + WS_BAR), MISC, tid0);
    }
    for (int ph = ph_lo; ph < ph_hi; ++ph) {
        unsigned ones = ~0u; asm volatile("" : "+s"(ones));
        int lane_l = __builtin_amdgcn_mbcnt_hi(ones, __builtin_amdgcn_mbcnt_lo(ones, 0u)); asm volatile("" : "+v"(lane_l));
        CArgsP ap = (CArgsP)__builtin_amdgcn_kernarg_segment_ptr(); asm volatile("" : "+s"(ap));
        const Args& A = *(const Args*)ap;
        const int lane = lane_l, tid = wid * 64 + lane;
        int bid = (int)blockIdx.x; asm volatile("" : "+s"(bid));
        unsigned char* ws = A.ws;
        bf16* Hb = (bf16*)(ws + WS_H); bf16* PPb = (bf16*)(ws + WS_PP);
        unsigned long long tail_mask = 0ull; int tail_nwg = 0;
        if (ph == 0) { p0_prologue(A, lds, tid, lane, wid); }
        else {
            int L, s;
            if (ph <= 20) { L = (ph - 1) / 10; const int t = (ph - 1) % 10; s = t < 3 ? t : (t == 3 ? 9 : t - 1); } else { const int q = ph - 21; L = 2 + q / 8; s = q % 8; s = s < 4 ? s : s + 1; }
            const bool isA = L < 2; const int jl = L - 2;
            bf16* XB = (bf16*)(ws + ((L & 1) ? WS_XB2 : WS_XB)); bf16* XBn = (bf16*)(ws + ((L & 1) ? WS_XB : WS_XB2));
            float* SS0 = (float*)(ws + WS_SS); float* SS1 = (float*)(ws + WS_SS2);
            unsigned char* wl = ws + WS_W + (size_t)L * WL_STRIDE;
            if (s == 0 || s == 6) {
                pg8::Gemm g{XB, (const bf16*)(wl + (s == 0 ? WL_WI1 : WL_WI2)), MPAD, 2 * DFF, DM};
                pg8::EpiSwiGLU E{Hb, DFF, SS0};
                GEMM_RUN(pg8::EpiSwiGLU, g, E);
                tail_mask = tail_jobs(L, s); tail_nwg = (MPAD / 256) * (2 * DFF / 256);
                if (s == 0 && L == 2) {
                    pg8::Gemm g2{XB, (const bf16*)(ws + WS_WKV), MPAD, 512, DM};
                    pg8::EpiF32 E2{(float*)(ws + WS_KVRAW), 512, SS0, nullptr};
                    GEMM_RUN(pg8::EpiF32, g2, E2);
                }
            } else if (s == 1 || s == 7) {
                if (s == 1 && L == 2) kv_finalize(A, lane, wid);
                pg8::Gemm g{Hb, (const bf16*)(wl + (s == 1 ? WL_WO1 : WL_WO2)), MP, DM, DFF};
                pg8::EpiRes E{XB, nullptr, XB, SS1, nullptr, nullptr, 0.5f, 0, MPAD};
                GEMM_RUN(pg8::EpiRes, g, E);
                Thin T{Hb, g.Bt, DFF, 0, XB, nullptr, XB, SS1, nullptr, nullptr, nullptr, 0.5f};
                thin_gemm(lds, T, tid, lane, wid, bid);
            } else if (s == 2) {
                if (isA) { pg8::Gemm g{XB, (const bf16*)(ws + WS_WA + (size_t)L * WA_STRIDE + WA_WIN), MPAD, NINP, DM};
                    pg8::EpiSplit E{(bf16*)(ws + WS_Z), DIN, 8, (bf16*)(ws + WS_XBC), CONVD, 24, (float*)(ws + WS_DT), SS1};
                    GEMM_RUN(pg8::EpiSplit, g, E);
                    tail_mask = tail_jobs(L, s); tail_nwg = (MPAD / 256) * (NINP / 256);
                } else { pg8::Gemm g{XB, (const bf16*)(ws + WS_WB + (size_t)jl * WB_STRIDE + WB_WQ), MP, DM, DM};
                    pg8::EpiSplit E{(bf16*)(ws + WS_Q), DM, 4, (bf16*)(ws + WS_Q), DM, 4, (float*)(ws + WS_DT), SS1};
                    GEMM_RUN(pg8::EpiSplit, g, E);
                    Thin T{XB, g.Bt, DM, 2, nullptr, nullptr, nullptr, nullptr, SS1, nullptr, (bf16*)(ws + WS_Q), 1.0f};
                    thin_gemm(lds, T, tid, lane, wid, bid); }
            } else if (s == 3) {
                if (isA) ssd_phase(A, lds, L, tid, lane, wid); else attn_phase(A, lds, jl, tid, lane, wid);
            } else if (s == 9) {
                ssd_pre_phase(A, L, tid, lane, wid);
            } else if (s == 4) {
                if (isA) gnorm_phase(A, tid);
            } else if (s == 5) {
                pg8::Gemm g{isA ? (const bf16*)(ws + WS_YG) : (const bf16*)(ws + WS_O), isA ? (const bf16*)(ws + WS_WA + (size_t)L * WA_STRIDE + WA_WOUT) : (const bf16*)(ws + WS_WB + (size_t)jl * WB_STRIDE + WB_WO), MP, DM, isA ? DIN : DM};
                pg8::EpiRes E{XB, nullptr, XB, SS0, nullptr, nullptr, 1.0f, 0, MPAD};
                GEMM_RUN(pg8::EpiRes, g, E);
                Thin T{g.A, g.Bt, g.K, 0, XB, nullptr, XB, SS0, nullptr, nullptr, nullptr, 1.0f};
                thin_gemm(lds, T, tid, lane, wid, bid);
            } else {
                pg8::Gemm g1{(const bf16*)(ws + WS_P16) + (size_t)L * MPAD * DPLE, (const bf16*)(wl + WL_WP), MP, DM, DPLE};
                pg8::EpiF32 E1{nullptr, DM, nullptr, PPb};
                GEMM_RUN(pg8::EpiF32, g1, E1);
                pg8::Gemm g2{XB, (const bf16*)(wl + WL_WG), MP, DM, DM};
                const bool last = (L == NLAYER - 1);
                float* xo = last ? A.out + O_Y : nullptr;
                pg8::EpiRes E2{XB, xo, XBn, SS0, SS1, PPb, 1.0f, 1, MPAD};
                GEMM_RUN(pg8::EpiRes, g2, E2);
                Thin T1{g1.A, g1.Bt, DPLE, 3, nullptr, nullptr, nullptr, nullptr, nullptr, PPb, nullptr, 1.0f};
                thin_gemm(lds, T1, tid, lane, wid, bid);
                Thin T2{XB, g2.Bt, DM, 1, XB, xo, XBn, SS0, SS1, PPb, nullptr, 1.0f};
                thin_gemm(lds, T2, tid, lane, wid, bid);
            }
        }
        if (ph > 0 && tail_mask) {
            const int G = (int)gridDim.x, rem = tail_nwg % G;
            if (rem != 0 && bid >= rem) convert_weights(A, lds, lane, wid, tail_mask, (bid - rem) * 8 + wid, (G - rem) * 8);
        }
        if (ph + 1 < ph_hi) {
            if (ph_hi < 0) cg::this_grid().sync();
            xcd_barrier(gbar, tid);
        }
    }
}

extern "C" void kernel_launch(void* const* d_in, const int* in_sizes, int n_in, void* d_out, int out_size, void* d_ws, size_t ws_size, hipStream_t stream) {
    static int grid = 0;
    if (grid == 0) {
        if (n_in != 33 || ws_size < WS_END) { fprintf(stderr, "kernel_launch: unexpected n_in %d or ws_size %zu (need %zu)\n", n_in, ws_size, (size_t)WS_END); grid = -1; return; }
        int dev = 0, cus = 0, per_cu = 0;
        hipGetDevice(&dev); hipDeviceGetAttribute(&cus, hipDeviceAttributeMultiprocessorCount, dev);
        if (hipFuncSetAttribute((const void*)yoco_fwd, hipFuncAttributeMaxDynamicSharedMemorySize, LDS_BYTES) != hipSuccess) { fprintf(stderr, "kernel_launch: hipFuncSetAttribute failed\n"); grid = -1; return; }
        if (hipOccupancyMaxActiveBlocksPerMultiprocessor(&per_cu, (const void*)yoco_fwd, 512, LDS_BYTES) != hipSuccess || per_cu < 1) { fprintf(stderr, "kernel_launch: occupancy query says %d\n", per_cu); per_cu = 1; }
        (void)hipGetLastError();
        grid = cus * 1;
        if (grid <= 0) grid = 256;
    }
    if (grid < 0) return;
    Args a{};
    for (int i = 0; i < 33; ++i) a.in[i] = (const float*)d_in[i];
    a.out = (float*)d_out; a.ws = (unsigned char*)d_ws;
#if MK_MULTI
    for (int ph = 0; ph < NPHASE; ++ph) {
        a.ph_lo = ph; a.ph_hi = ph + 1;
        hipLaunchKernelGGL(yoco_fwd, dim3(grid), dim3(512), LDS_BYTES, stream, a);
    }
#else
    (void)hipMemsetAsync((unsigned char*)d_ws + WS_BAR, 0, BAR_BYTES, stream);
    a.ph_lo = 0; a.ph_hi = NPHASE;
    void* args[] = {&a};
    hipError_t e = hipLaunchCooperativeKernel((const void*)yoco_fwd, dim3(grid), dim3(512), args, LDS_BYTES, stream);
    if (e != hipSuccess) fprintf(stderr, "cooperative launch failed: %s (grid %d)\n", hipGetErrorString(e), grid);
#endif
}
```

```cpp
#include <hip/hip_runtime.h>
#include <hip/hip_cooperative_groups.h>
#include <cstdio>
#include <cstdint>
namespace cg = cooperative_groups;
namespace pg8 {
#define PG8_LAS __attribute__((address_space(3)))
typedef unsigned short bf16_t;
typedef short bf16x8 __attribute__((ext_vector_type(8)));
typedef float f32x4 __attribute__((ext_vector_type(4)));
typedef unsigned u32x4 __attribute__((ext_vector_type(4)));
constexpr int BM = 256, BK = 64, HALF = 128, HTB = HALF * BK * 2  , STAGE_BYTES = 8 * HTB, NXCD = 8, WGM = 8;

__host__ __device__ __forceinline__ int lds_byte(int r, int c) { const int st = (r >> 4) * 2 + (c >> 5), rr = r & 15, cc = c & 31, ob = rr * 64 + cc * 2; return st * 1024 + (ob ^ (((ob >> 9) & 1) << 5)); }
__host__ __device__ __forceinline__ void stage_rc(int b, int& R, int& C) { const int st = b / 1024, sb = b % 1024, swz = sb ^ (((sb >> 9) & 1) << 5); R = (st >> 1) * 16 + swz / 64; C = (st & 1) * 32 + (swz % 64) / 2; }
__host__ __device__ __forceinline__ int perm32(int rho) { const int n = rho >> 4, i = rho & 15; return 8 * (i >> 2) + 4 * n + (i & 3); }

struct Unit { int pm, pn; };
struct Gemm { const bf16_t* A; const bf16_t* Bt; int M, N, K; };

struct StaticOrder {
    int nM, nN, nwg, G, c;
    __host__ __device__ void init(int M, int N, int G_, int c_) { nM = M / BM; nN = N / BM; nwg = nM * nN; G = G_; c = c_; }
    __host__ __device__ bool next(int i, Unit& u) const {
        const long L = (long)i * G + c; if (L >= nwg) return false;
        int wgid = (int)L; { const int q = nwg / NXCD, r = nwg % NXCD, xcd = wgid % NXCD, off = wgid / NXCD; wgid = (xcd < r ? xcd * (q + 1) : r * (q + 1) + (xcd - r) * q) + off; }
        const int nig = WGM * nN, gid = wgid / nig, fm = gid * WGM, gsz = (nM - fm) < WGM ? (nM - fm) : WGM;
        u.pm = fm + ((wgid % nig) % gsz); u.pn = (wgid % nig) / gsz; return true;
    }
    __device__ __forceinline__ void a_ready(const Unit&) const {}
    __device__ __forceinline__ void done(const Unit&) const {}
};


typedef float f32x2_t __attribute__((ext_vector_type(2)));
typedef __bf16 bf16x2_t __attribute__((ext_vector_type(2)));
__device__ __forceinline__ unsigned cvt_pk_bf16(float lo, float hi) { f32x2_t v = {lo, hi}; bf16x2_t b = __builtin_convertvector(v, bf16x2_t); return __builtin_bit_cast(unsigned, b); }
typedef unsigned u32x2 __attribute__((ext_vector_type(2)));
constexpr float RMS_EPS = 1e-6f;
__device__ __forceinline__ float rstd_row(const float* SS, int row) {
    const f32x4* p = (const f32x4*)(SS + (size_t)row * 16);
    const f32x4 a = p[0], b = p[1], c = p[2], d = p[3];
    const float s = ((a[0] + a[1]) + (a[2] + a[3])) + ((b[0] + b[1]) + (b[2] + b[3])) + ((c[0] + c[1]) + (c[2] + c[3])) + ((d[0] + d[1]) + (d[2] + d[3]));
    return __builtin_amdgcn_rsqf(s * (1.0f / 1024.0f) + RMS_EPS);
}
__device__ __forceinline__ float sigmoid_f(float v) { return __builtin_amdgcn_rcpf(1.0f + __expf(-v)); }

struct EpiSwiGLU {
    static constexpr bool PERM = true, AFTER_DRAIN = false;
    bf16_t* H; int ldh; const float* SS;
    __device__ __forceinline__ void operator()(const f32x4 (&acc)[2][2][4][2], const Unit& u, int wr, int wc, int fr, int fq) const {
        const int row0 = u.pm * BM + wr * 64 + fr; const int col0 = u.pn * 128 + wc * 32 + 8 * fq;
#pragma unroll
        for (int ai = 0; ai < 2; ++ai)
#pragma unroll
            for (int m = 0; m < 4; ++m) {
                const int row = row0 + ai * HALF + m * 16; const float rs = rstd_row(SS, row);
                float h[8];
#pragma unroll
                for (int n = 0; n < 2; ++n)
#pragma unroll
                    for (int e = 0; e < 4; ++e) { const float g = acc[ai][0][m][n][e] * rs, up = acc[ai][1][m][n][e] * rs; h[n * 4 + e] = g * sigmoid_f(g) * up; }
                u32x4 w; w.x = cvt_pk_bf16(h[0], h[1]); w.y = cvt_pk_bf16(h[2], h[3]); w.z = cvt_pk_bf16(h[4], h[5]); w.w = cvt_pk_bf16(h[6], h[7]);
                *(u32x4*)(H + (size_t)row * ldh + col0) = w;
            }
    }
};
struct EpiSplit {
    static constexpr bool PERM = true, AFTER_DRAIN = false;
    bf16_t* O0; int ld0; int t1; bf16_t* O1; int ld1; int t2; float* DT; const float* SS;
    __device__ __forceinline__ void operator()(const f32x4 (&acc)[2][2][4][2], const Unit& u, int wr, int wc, int fr, int fq) const {
        const int row0 = u.pm * BM + wr * 64 + fr;
        bf16_t* base; int ld, colt;
        if (u.pn < t1) { base = O0; ld = ld0; colt = u.pn * BM; } else { base = O1; ld = ld1; colt = (u.pn - t1) * BM; }
        const bool isdt = u.pn >= t2;
        const int col0 = colt + wc * 32 + 8 * fq;
#pragma unroll
        for (int ai = 0; ai < 2; ++ai)
#pragma unroll
            for (int m = 0; m < 4; ++m) {
                const int row = row0 + ai * HALF + m * 16; const float rs = rstd_row(SS, row);
                if (!isdt) {
#pragma unroll
                    for (int bj = 0; bj < 2; ++bj) { const f32x4 v0 = acc[ai][bj][m][0] * rs, v1 = acc[ai][bj][m][1] * rs;
                        u32x4 w; w.x = cvt_pk_bf16(v0[0], v0[1]); w.y = cvt_pk_bf16(v0[2], v0[3]); w.z = cvt_pk_bf16(v1[0], v1[1]); w.w = cvt_pk_bf16(v1[2], v1[3]);
                        *(u32x4*)(base + (size_t)row * ld + col0 + bj * HALF) = w; }
                } else if (wc == 0) {
                    float* d = DT + (size_t)row * 32 + 8 * fq;
                    *(f32x4*)d = acc[ai][0][m][0] * rs; *(f32x4*)(d + 4) = acc[ai][0][m][1] * rs;
                }
            }
    }
};
struct EpiF32 {
    static constexpr bool PERM = false, AFTER_DRAIN = false;
    float* O; int ldo; const float* SS; bf16_t* OB;
    __device__ __forceinline__ void operator()(const f32x4 (&acc)[2][2][4][2], const Unit& u, int wr, int wc, int fr, int fq) const {
        const int row0 = u.pm * BM + wr * 64 + fr; const int col0 = u.pn * BM + wc * 32 + 4 * fq;
#pragma unroll
        for (int ai = 0; ai < 2; ++ai)
#pragma unroll
            for (int m = 0; m < 4; ++m) {
                const int row = row0 + ai * HALF + m * 16; const float rs = SS ? rstd_row(SS, row) : 1.0f;
#pragma unroll
                for (int bj = 0; bj < 2; ++bj)
#pragma unroll
                    for (int n = 0; n < 2; ++n) { const f32x4 v = acc[ai][bj][m][n] * rs; const size_t o_ = (size_t)row * ldo + col0 + bj * HALF + n * 16;
                        if (OB) { u32x2 w; w.x = cvt_pk_bf16(v[0], v[1]); w.y = cvt_pk_bf16(v[2], v[3]); *(u32x2*)(OB + o_) = w; } else *(f32x4*)(O + o_) = v; }
            }
    }
};
struct EpiRes {
    static constexpr bool PERM = false, AFTER_DRAIN = false;
    const bf16_t* XBin; float* Xout; bf16_t* XB; float* SSout; const float* SSin; const bf16_t* PP; float scale; int mode; int mreal;
    __device__ __forceinline__ void operator()(const f32x4 (&acc)[2][2][4][2], const Unit& u, int wr, int wc, int fr, int fq) const {
        const int row0 = u.pm * BM + wr * 64 + fr; const int col0 = u.pn * BM + wc * 32 + 4 * fq;
#pragma unroll
        for (int ai = 0; ai < 2; ++ai)
#pragma unroll
            for (int m = 0; m < 4; ++m) {
                const int row = row0 + ai * HALF + m * 16; const size_t off = (size_t)row * 1024 + col0;
                const float rs = (mode == 1) ? rstd_row(SSin, row) : 0.0f;
                float ssq = 0.f;
#pragma unroll
                for (int bj = 0; bj < 2; ++bj)
#pragma unroll
                    for (int n = 0; n < 2; ++n) {
                        const u32x2 xb = *(const u32x2*)(XBin + off + bj * HALF + n * 16); const f32x4 a = acc[ai][bj][m][n];
                        f32x4 x4 = (f32x4){__uint_as_float(xb.x << 16), __uint_as_float(xb.x & 0xffff0000u), __uint_as_float(xb.y << 16), __uint_as_float(xb.y & 0xffff0000u)};
                        if (mode == 1) { const u32x2 pw = *(const u32x2*)(PP + off + bj * HALF + n * 16);
                            const f32x4 p4 = (f32x4){__uint_as_float(pw.x << 16), __uint_as_float(pw.x & 0xffff0000u), __uint_as_float(pw.y << 16), __uint_as_float(pw.y & 0xffff0000u)};
#pragma unroll
                            for (int e = 0; e < 4; ++e) x4[e] += sigmoid_f(a[e] * rs) * p4[e];
                        } else x4 += a * scale;
                        ssq += (x4[0] * x4[0] + x4[1] * x4[1]) + (x4[2] * x4[2] + x4[3] * x4[3]);
                        if (Xout) *(f32x4*)(Xout + off + bj * HALF + n * 16) = x4;
                        u32x2 w; w.x = cvt_pk_bf16(x4[0], x4[1]); w.y = cvt_pk_bf16(x4[2], x4[3]); *(u32x2*)(XB + off + bj * HALF + n * 16) = w;
                    }
                ssq += __shfl_xor(ssq, 16); ssq += __shfl_xor(ssq, 32);
                if (fq == 0) SSout[(size_t)row * 16 + u.pn * 4 + wc] = ssq;
                if (m & 1) asm volatile("" ::: "memory");
            }
    }
};

template <class Epi, class Sched, bool ALIGN_EPI = false, bool SP2 = false>
__device__ __forceinline__ void gemm_phase(PG8_LAS unsigned char* lds, const Gemm g, const Sched& S, const Epi& E, int tid_in) {
    int tid_l = tid_in; asm volatile("" : "+v"(tid_l));
    const int tid = tid_l, wid = __builtin_amdgcn_readfirstlane(tid >> 6), lane = tid & 63, wr = wid >> 2, wc = wid & 3, fr = lane & 15, fq = lane >> 4;
    const int K = g.K, nt = K / BK;
    unsigned voffA[2], voffB[2];
#pragma unroll
    for (int i = 0; i < 2; ++i) { int R, C; stage_rc(tid * 16 + i * 8192, R, C); const int Rb = Epi::PERM ? ((R & ~31) + perm32(R & 31)) : R;
        voffA[i] = (unsigned)(R * K + C) * 2u; voffB[i] = (unsigned)(Rb * K + C) * 2u; }
    const size_t kstep = (size_t)(BK * 2);
    const size_t hstep = (size_t)HALF * K * 2;
    const size_t tstep = 2 * hstep;
    const unsigned ldsw = (unsigned)wid * 1024u;
    const int aoff = lds_byte(wr * 64 + fr, fq * 8), boff = lds_byte(wc * 32 + fr, fq * 8);
#define PG8_SA(b, h) (((b) * 2 + (h)) * HTB)
#define PG8_SB(b, h) ((4 + (b) * 2 + (h)) * HTB)
#define PG8_STAGE(bufoff, gbase, voff) do { _Pragma("unroll") for (int _i = 0; _i < 2; ++_i) \
        __builtin_amdgcn_global_load_lds((const unsigned*)((const char*)(gbase) + (voff)[_i]), (PG8_LAS unsigned*)(lds + (bufoff) + ldsw + _i * 8192), 16, 0, 0); } while (0)
#define PG8_LDA(dst, b, h) do { _Pragma("unroll") for (int m = 0; m < 4; ++m) _Pragma("unroll") for (int k = 0; k < 2; ++k) dst[m][k] = *(const PG8_LAS bf16x8*)(lds + PG8_SA(b, h) + aoff + m * 2048 + k * 1024); } while (0)
#define PG8_LDB(dst, b, h) do { _Pragma("unroll") for (int n = 0; n < 2; ++n) _Pragma("unroll") for (int k = 0; k < 2; ++k) dst[n][k] = *(const PG8_LAS bf16x8*)(lds + PG8_SB(b, h) + boff + n * 2048 + k * 1024); } while (0)
#define PG8_MMA(ai, bj, At, Bt) do { __builtin_amdgcn_s_setprio(1); _Pragma("unroll") for (int m = 0; m < 4; ++m) _Pragma("unroll") for (int n = 0; n < 2; ++n) _Pragma("unroll") for (int k = 0; k < 2; ++k) \
        acc[ai][bj][m][n] = __builtin_amdgcn_mfma_f32_16x16x32_bf16(Bt[n][k], At[m][k], acc[ai][bj][m][n], 0, 0, 0); __builtin_amdgcn_s_setprio(0); } while (0)
#define PG8_WAIT_V(n) asm volatile("s_waitcnt vmcnt(" #n ")" ::: "memory")
#define PG8_WAIT_L(n) asm volatile("s_waitcnt lgkmcnt(" #n ")" ::: "memory")
#define PG8_BAR __builtin_amdgcn_s_barrier()
#define PG8_SCHED __builtin_amdgcn_sched_barrier(0)
    Unit cur, nxt; int ui = 0;
    if (!S.next(0, cur)) return;
    f32x4 acc[2][2][4][2];
#pragma unroll
    for (int a = 0; a < 2; ++a)
#pragma unroll
        for (int b = 0; b < 2; ++b)
#pragma unroll
            for (int m = 0; m < 4; ++m)
#pragma unroll
                for (int n = 0; n < 2; ++n) acc[a][b][m][n] = (f32x4){0.f, 0.f, 0.f, 0.f};
    bf16x8 At[4][2], B0[2][2], B1[2][2];
    const char* cA = (const char*)g.A + (size_t)cur.pm * tstep; const char* cB = (const char*)g.Bt + (size_t)cur.pn * tstep;
    S.a_ready(cur);
    if constexpr (SP2) {
        PG8_STAGE(PG8_SB(0, 0), cB, voffB); PG8_STAGE(PG8_SB(0, 1), cB + hstep, voffB); PG8_STAGE(PG8_SA(0, 0), cA, voffA); PG8_STAGE(PG8_SA(0, 1), cA + hstep, voffA);
        if (wr == 1) PG8_BAR;
        PG8_WAIT_V(2); PG8_BAR;
        PG8_STAGE(PG8_SB(1, 0), cB + kstep, voffB); PG8_STAGE(PG8_SA(1, 0), cA + kstep, voffA); PG8_STAGE(PG8_SB(1, 1), cB + hstep + kstep, voffB);
        PG8_WAIT_V(6); PG8_BAR;
    } else {
        PG8_STAGE(PG8_SB(0, 0), cB, voffB); PG8_STAGE(PG8_SA(0, 0), cA, voffA); PG8_STAGE(PG8_SB(0, 1), cB + hstep, voffB); PG8_STAGE(PG8_SA(0, 1), cA + hstep, voffA);
        if (wr == 1) PG8_BAR;
        PG8_WAIT_V(4); PG8_BAR;
        PG8_STAGE(PG8_SB(1, 0), cB + kstep, voffB); PG8_STAGE(PG8_SA(1, 0), cA + kstep, voffA); PG8_STAGE(PG8_SB(1, 1), cB + hstep + kstep, voffB);
        PG8_WAIT_V(6); PG8_BAR;
    }
    for (;;) {
        const bool has_next = S.next(ui + 1, nxt);
        const char* nA = has_next ? (const char*)g.A + (size_t)nxt.pm * tstep : cA; const char* nB = has_next ? (const char*)g.Bt + (size_t)nxt.pn * tstep : cB;
        for (int t = 0; t < nt; t += 2) {
            const bool last = (t == nt - 2);
            const char* a1 = cA + (size_t)(t + 1) * kstep;
            const char* a2 = last ? nA : cA + (size_t)(t + 2) * kstep; const char* b2 = last ? nB : cB + (size_t)(t + 2) * kstep;
            const char* a3 = a2 + kstep; const char* b3 = b2 + kstep;
            if (last && has_next) S.a_ready(nxt);
            if constexpr (SP2) {
            PG8_LDB(B0, 0, 0); PG8_LDB(B1, 0, 1); PG8_SCHED; PG8_LDA(At, 0, 0); PG8_STAGE(PG8_SA(1, 1), a1 + hstep, voffA);
            PG8_WAIT_V(8); PG8_WAIT_L(0); PG8_BAR; PG8_MMA(0, 0, At, B0); PG8_MMA(0, 1, At, B1); PG8_BAR; PG8_SCHED;
            PG8_LDA(At, 0, 1); PG8_STAGE(PG8_SB(0, 0), b2, voffB); PG8_STAGE(PG8_SB(0, 1), b2 + hstep, voffB); PG8_STAGE(PG8_SA(0, 0), a2, voffA);
            PG8_WAIT_V(8); PG8_WAIT_L(0); PG8_BAR; PG8_MMA(1, 0, At, B0); PG8_MMA(1, 1, At, B1); PG8_BAR; PG8_SCHED;
            PG8_LDB(B0, 1, 0); PG8_LDB(B1, 1, 1); PG8_SCHED; PG8_LDA(At, 1, 0); PG8_STAGE(PG8_SA(0, 1), a2 + hstep, voffA);
            PG8_WAIT_V(8); PG8_WAIT_L(0); PG8_BAR; PG8_MMA(0, 0, At, B0); PG8_MMA(0, 1, At, B1); PG8_BAR; PG8_SCHED;
            PG8_LDA(At, 1, 1); PG8_STAGE(PG8_SB(1, 0), b3, voffB); PG8_STAGE(PG8_SB(1, 1), b3 + hstep, voffB); PG8_STAGE(PG8_SA(1, 0), a3, voffA);
            PG8_WAIT_V(8); PG8_WAIT_L(0); PG8_BAR; PG8_MMA(1, 0, At, B0); PG8_MMA(1, 1, At, B1); PG8_BAR; PG8_SCHED;
            } else {
            PG8_LDB(B0, 0, 0); PG8_SCHED; PG8_LDA(At, 0, 0); PG8_STAGE(PG8_SA(1, 1), a1 + hstep, voffA);
            PG8_WAIT_L(8); PG8_BAR; PG8_WAIT_L(0); PG8_MMA(0, 0, At, B0); PG8_BAR; PG8_SCHED;
            PG8_LDB(B1, 0, 1); PG8_STAGE(PG8_SB(0, 0), b2, voffB);
            PG8_BAR; PG8_WAIT_L(0); PG8_MMA(0, 1, At, B1); PG8_BAR;
            PG8_LDA(At, 0, 1); PG8_STAGE(PG8_SA(0, 0), a2, voffA);
            PG8_BAR; PG8_WAIT_L(0); PG8_MMA(1, 0, At, B0); PG8_BAR; PG8_SCHED;
            PG8_STAGE(PG8_SB(0, 1), b2 + hstep, voffB);
            PG8_WAIT_V(6); PG8_BAR; PG8_MMA(1, 1, At, B1); PG8_BAR;
            PG8_LDB(B0, 1, 0); PG8_SCHED; PG8_LDA(At, 1, 0); PG8_STAGE(PG8_SA(0, 1), a2 + hstep, voffA);
            PG8_WAIT_L(8); PG8_BAR; PG8_WAIT_L(0); PG8_MMA(0, 0, At, B0); PG8_BAR; PG8_SCHED;
            PG8_LDB(B1, 1, 1); PG8_STAGE(PG8_SB(1, 0), b3, voffB);
            PG8_BAR; PG8_WAIT_L(0); PG8_MMA(0, 1, At, B1); PG8_BAR;
            PG8_LDA(At, 1, 1); PG8_STAGE(PG8_SA(1, 0), a3, voffA);
            PG8_BAR; PG8_WAIT_L(0); PG8_MMA(1, 0, At, B0); PG8_BAR; PG8_SCHED;
            PG8_STAGE(PG8_SB(1, 1), b3 + hstep, voffB);
            PG8_WAIT_V(6); PG8_BAR; PG8_MMA(1, 1, At, B1); PG8_BAR;
            }
        }
        if constexpr (ALIGN_EPI) { if (wr == 0) PG8_BAR; }
        if constexpr (!Epi::AFTER_DRAIN) { E(acc, cur, wr, wc, fr, fq); S.done(cur); }
        if (!has_next) break;
#pragma unroll
        for (int a = 0; a < 2; ++a)
#pragma unroll
            for (int b = 0; b < 2; ++b)
#pragma unroll
                for (int m = 0; m < 4; ++m)
#pragma unroll
                    for (int n = 0; n < 2; ++n) acc[a][b][m][n] = (f32x4){0.f, 0.f, 0.f, 0.f};
        cur = nxt; cA = nA; cB = nB; ++ui;
        if constexpr (ALIGN_EPI) { if (wr == 1) PG8_BAR; }
    }
    PG8_WAIT_V(0);
    if constexpr (!ALIGN_EPI) { if (wr == 0) PG8_BAR; }
    PG8_BAR;
    if constexpr (Epi::AFTER_DRAIN) { E.fused(acc, cur, wr, wc, fr, fq, lds, wid, lane); S.done(cur); }
#undef PG8_SA
#undef PG8_SB
#undef PG8_STAGE
#undef PG8_LDA
#undef PG8_LDB
#undef PG8_MMA
#undef PG8_WAIT_V
#undef PG8_WAIT_L
#undef PG8_BAR
#undef PG8_SCHED
}
}

#define LAS __attribute__((address_space(3)))
#define XB_TMO      128
#define XB_XCNT(j)  (256  + 64 * (j))
#define XB_XSUB(j)  (1280 + 64 * (j))
#define XB_XGEN(j)  (2304 + 64 * (j))
#define XB_TOP      3328
#define XB_TOPGEN   3392
#define XCD_BAR_WORDS 3456
#define XB_SPIN_CAP (1u << 18)

__device__ __forceinline__ unsigned xb_ld(unsigned* p)              { return __hip_atomic_load(p, __ATOMIC_RELAXED, __HIP_MEMORY_SCOPE_AGENT); }
__device__ __forceinline__ unsigned xb_add(unsigned* p, unsigned v) { return __hip_atomic_fetch_add(p, v, __ATOMIC_RELAXED, __HIP_MEMORY_SCOPE_AGENT); }
__device__ __forceinline__ unsigned xb_xcc_id() { return (unsigned)__builtin_amdgcn_s_getreg((3 << 11) | 20) & 0xFu; }
#define XB_SPIN(cond, bar) do { unsigned _sp = 0; while (cond) { __builtin_amdgcn_s_sleep(1); \
    if ((++_sp & 255u) == 0u) { if (xb_ld(&(bar)[XB_TMO])) break; if (_sp > XB_SPIN_CAP) { atomicAdd(&(bar)[XB_TMO], 1u); break; } } } } while (0)

struct XcdBarrier {
    unsigned* bar; unsigned x;
    volatile LAS unsigned* st;
};

__device__ __forceinline__ XcdBarrier xcd_barrier_post(unsigned* bar, volatile LAS unsigned* st, int tid) {
    XcdBarrier b; b.bar = bar; b.x = xb_xcc_id(); b.st = st;
    if (tid == 0) (void)xb_add(&bar[XB_XCNT(b.x)], 1u);
    return b;
}
__device__ __forceinline__ void xcd_barrier_complete(unsigned* bar, unsigned x, unsigned& nloc, unsigned& nx) {
    const unsigned G = gridDim.x * gridDim.y * gridDim.z;
    unsigned sum, cnt, mine, sp = 0u;
    for (;;) {
        sum = 0u; cnt = 0u; mine = 0u;
#pragma unroll
        for (unsigned j = 0; j < 16; ++j) { const unsigned c = xb_ld(&bar[XB_XCNT(j)]); sum += c; cnt += (c > 0u) ? 1u : 0u; mine = (j == x) ? c : mine; }
        if (sum == G) break;
        __builtin_amdgcn_s_sleep(1);
        if ((++sp & 255u) == 0u) { if (xb_ld(&bar[XB_TMO])) break; if (sp > XB_SPIN_CAP) { atomicAdd(&bar[XB_TMO], 1u); break; } }
    }
    nloc = mine > 0u ? mine : 1u; nx = cnt > 0u ? cnt : 1u;
}

__device__ __forceinline__ void xcd_barrier(const XcdBarrier& b, int tid) {
    asm volatile("s_waitcnt vmcnt(0)" ::: "memory");
    __syncthreads();
    if (tid == 0) {
        unsigned* bar = b.bar;
        __builtin_amdgcn_s_waitcnt(0);
        unsigned nloc = b.st[0], nx = b.st[1];
        if (nloc == 0u) { xcd_barrier_complete(bar, b.x, nloc, nx); b.st[0] = nloc; b.st[1] = nx; }
        const unsigned old = xb_add(&bar[XB_XSUB(b.x)], 1u);
        const unsigned gen = old / nloc;
        if (old + 1u == (gen + 1u) * nloc) {
            __builtin_amdgcn_fence(__ATOMIC_RELEASE, "agent");
            asm volatile("s_waitcnt vmcnt(0)" ::: "memory");
            const unsigned og = xb_add(&bar[XB_TOP], 1u);
            const unsigned tg = og / nx;
            if (og + 1u == (tg + 1u) * nx) xb_add(&bar[XB_TOPGEN], 1u);
            else XB_SPIN(xb_ld(&bar[XB_TOPGEN]) == tg, bar);
            __builtin_amdgcn_fence(__ATOMIC_ACQUIRE, "agent");
            xb_add(&bar[XB_XGEN(b.x)], 1u);
            asm volatile("s_waitcnt vmcnt(0)" ::: "memory");
        } else {
            XB_SPIN(xb_ld(&bar[XB_XGEN(b.x)]) == gen, bar);
            __builtin_amdgcn_fence(__ATOMIC_ACQUIRE, "agent");
            asm volatile("s_waitcnt vmcnt(0)" ::: "memory");
        }
    }
    __syncthreads();
}


#ifndef MK_MULTI
#define MK_MULTI 0
#endif
constexpr int DM = 1024, NB = 8, SEQ = 2048, MP = NB * SEQ, MS = 128, MR = MP + MS, MPAD = 16640;
constexpr int DFF = 2816, DPLE = 256, DIN = 2048, CONVD = 4096, NH = 32, DST = 128;
constexpr int NIN = 6176, NINP = 6400, NLAYER = 4;
constexpr int PAST = 8192;
constexpr size_t MiB = 1u << 20;
constexpr size_t WS_SS = 0, WS_ROPE = 2 * MiB, WS_GSQ = 3 * MiB, WS_DT = 8 * MiB, WS_KF = 12 * MiB, WS_VT = 20 * MiB, WS_KVRAW = 28 * MiB;
constexpr size_t WS_X = 62 * MiB, WS_XB = 128 * MiB, WS_H = 162 * MiB, WS_PP = 252 * MiB, WS_P16 = 318 * MiB, WS_Z = 352 * MiB, WS_XBC = 418 * MiB, WS_YG = 548 * MiB;
constexpr size_t WS_Q = WS_Z, WS_O = WS_Z + 33 * MiB;
constexpr size_t WS_W = 614 * MiB;
constexpr size_t WL_STRIDE = 36 * MiB, WL_WI1 = 0, WL_WO1 = 11 * MiB, WL_WI2 = 17 * MiB, WL_WO2 = 28 * MiB, WL_WG = 34 * MiB - 512 * 1024, WL_WP = 36 * MiB - 512 * 1024;
constexpr size_t WS_WA = WS_W + 4 * WL_STRIDE, WA_STRIDE = 17 * MiB, WA_WIN = 0, WA_WOUT = 13 * MiB;
constexpr size_t WS_WB = WS_WA + 2 * WA_STRIDE, WB_STRIDE = 4 * MiB, WB_WQ = 0, WB_WO = 2 * MiB;
constexpr size_t WS_WKV = WS_WB + 2 * WB_STRIDE;
constexpr size_t WS_SS2 = WS_WKV + 1 * MiB, WS_XB2 = WS_SS2 + 2 * MiB;
constexpr size_t WS_BAR = WS_XB2 + 33 * MiB, BAR_BYTES = 65536;
constexpr size_t WS_END = WS_BAR + 1 * MiB;
static_assert(WS_END <= 1024 * MiB, "ws");
constexpr size_t O_Y = 0, O_SSMP = 16908288, O_CONVP = 21102592, O_KP = 21299200, O_VP = 21561344, O_SSMS = 21823488, O_CONVS = 88932352, O_KS = 92078080, O_VS = 96272384;
constexpr int LDS_BYTES = 160 * 1024;
constexpr int NPHASE = 1 + 2 * 10 + 2 * 8;

typedef unsigned short bf16;
typedef float f32x4 __attribute__((ext_vector_type(4)));
typedef float f32x16 __attribute__((ext_vector_type(16)));
typedef short bf16x8 __attribute__((ext_vector_type(8)));
typedef unsigned u32x4 __attribute__((ext_vector_type(4)));
typedef unsigned u32x2 __attribute__((ext_vector_type(2)));
using pg8::cvt_pk_bf16;
__device__ __forceinline__ float bflo(unsigned w) { return __uint_as_float(w << 16); }
__device__ __forceinline__ float bfhi(unsigned w) { return __uint_as_float(w & 0xffff0000u); }
__device__ __forceinline__ float bf1(bf16 h) { return __uint_as_float((unsigned)h << 16); }
__device__ __forceinline__ bf16 f2bf(float f) { return (bf16)(cvt_pk_bf16(f, 0.f) & 0xffffu); }
__device__ __forceinline__ float silu_f(float v) { return v * __builtin_amdgcn_rcpf(1.0f + __expf(-v)); }
__device__ __forceinline__ float wave_sum(float v) {
#pragma unroll
    for (int o = 1; o < 64; o <<= 1) v += __shfl_xor(v, o);
    return v;
}
__device__ __forceinline__ float wave_max(float v) {
#pragma unroll
    for (int o = 1; o < 64; o <<= 1) v = fmaxf(v, __shfl_xor(v, o));
    return v;
}
#define LDS_WAIT() asm volatile("s_waitcnt lgkmcnt(0)" ::: "memory")

struct Args { const float* in[33]; float* out; unsigned char* ws; int ph_lo, ph_hi; };
enum { I_XP = 0, I_XS, I_SSM, I_CONV, I_CK, I_CV, I_PP, I_PS, I_F1N, I_F1WI, I_F1WO, I_MIXN, I_F2N, I_F2WI, I_F2WO, I_PLEN, I_PLEG, I_PLEP,
       I_SIN, I_SCW, I_SCB, I_SDTB, I_SALOG, I_SD, I_SNORM, I_SOUT, I_KVN, I_WKV, I_KN, I_WQ, I_QN, I_SINK, I_WO };

__device__ __forceinline__ void tr_load(const float* W, int N, const float* gain, int item, int lane, float (&v)[32], float& gv) {
    const int nblk = N / 32, kb = item / nblk, nb = item % nblk, k0 = 64 * kb, n0 = 32 * nb;
    const float* wp = W + (size_t)(k0 + (lane >> 5)) * N + n0 + (lane & 31);
#pragma unroll
    for (int i = 0; i < 32; ++i) v[i] = wp[(size_t)(2 * i) * N];
    gv = gain ? gain[k0 + lane] : 1.0f;
}
__device__ __forceinline__ void tr_finish(float (&v)[32], float gv, int K, int N, bf16* WT, int mode, LAS float* scr, int item, int lane) {
    const int nblk = N / 32, kb = item / nblk, nb = item % nblk, k0 = 64 * kb, n0 = 32 * nb;
    int drow0 = n0;
    if (mode == 1) { if (n0 < DFF) drow0 = 256 * (n0 / 128) + (n0 % 128); else { const int j = n0 - DFF; drow0 = 256 * (j / 128) + 128 + (j % 128); } }
#pragma unroll
    for (int i = 0; i < 32; ++i) { const float g0 = __builtin_bit_cast(float, __builtin_amdgcn_readlane(__builtin_bit_cast(int, gv), 2 * i)), g1 = __builtin_bit_cast(float, __builtin_amdgcn_readlane(__builtin_bit_cast(int, gv), 2 * i + 1));
        scr[(2 * i + (lane >> 5)) * 33 + (lane & 31)] = v[i] * ((lane >> 5) ? g1 : g0); }
    LDS_WAIT(); asm volatile("" ::: "memory");
    const int c = lane & 7;
#pragma unroll
    for (int j = 0; j < 4; ++j) { const int n = (lane >> 3) + 8 * j; const LAS float* sp = scr + (8 * c) * 33 + n;
        u32x4 o; o.x = cvt_pk_bf16(sp[0 * 33], sp[1 * 33]); o.y = cvt_pk_bf16(sp[2 * 33], sp[3 * 33]); o.z = cvt_pk_bf16(sp[4 * 33], sp[5 * 33]); o.w = cvt_pk_bf16(sp[6 * 33], sp[7 * 33]);
        *(u32x4*)(WT + (size_t)(drow0 + n) * K + k0 + 8 * c) = o; }
    LDS_WAIT(); asm volatile("" ::: "memory");
}
__constant__ double ROPE_T8[8] = {1.0, 0.7498942093324559, 0.5623413251903491, 0.4216965034285822, 0.31622776601683794, 0.23713737056616552, 0.1778279410038923, 0.1333521432163324};
__constant__ double ROPE_P10[4] = {1.0, 0.1, 0.01, 0.001};

__device__ __forceinline__ void convert_weights(const Args& A, LAS unsigned char* lds, int lane, int wave, unsigned long long mask, int widx, int nw) {
    unsigned char* ws = A.ws;
    LAS float* scr = (LAS float*)(lds + wave * 16384);
#pragma unroll 1
    for (int job = 0; job < 33; ++job) {
        if (!((mask >> job) & 1ull)) continue;
        const float* src; bf16* dst; const float* gain = nullptr; int K, N, mode = 0;
        if (job < 24) { const int L = job / 6, k = job % 6; unsigned char* wl = ws + WS_W + (size_t)L * WL_STRIDE;
            if (k == 0)      { src = A.in[I_F1WI] + (size_t)L * DM * 2 * DFF; dst = (bf16*)(wl + WL_WI1); gain = A.in[I_F1N] + L * DM; K = DM; N = 2 * DFF; mode = 1; }
            else if (k == 1) { src = A.in[I_F1WO] + (size_t)L * DFF * DM;     dst = (bf16*)(wl + WL_WO1); K = DFF; N = DM; }
            else if (k == 2) { src = A.in[I_F2WI] + (size_t)L * DM * 2 * DFF; dst = (bf16*)(wl + WL_WI2); gain = A.in[I_F2N] + L * DM; K = DM; N = 2 * DFF; mode = 1; }
            else if (k == 3) { src = A.in[I_F2WO] + (size_t)L * DFF * DM;     dst = (bf16*)(wl + WL_WO2); K = DFF; N = DM; }
            else if (k == 4) { src = A.in[I_PLEG] + (size_t)L * DM * DM;      dst = (bf16*)(wl + WL_WG); gain = A.in[I_PLEN] + L * DM; K = DM; N = DM; }
            else             { src = A.in[I_PLEP] + (size_t)L * DPLE * DM;    dst = (bf16*)(wl + WL_WP); K = DPLE; N = DM; }
        } else if (job < 28) { const int a = (job - 24) / 2, k = (job - 24) % 2; unsigned char* wl = ws + WS_WA + (size_t)a * WA_STRIDE;
            if (k == 0) { src = A.in[I_SIN] + (size_t)a * DM * NIN;  dst = (bf16*)(wl + WA_WIN); gain = A.in[I_MIXN] + a * DM; K = DM; N = NIN; }
            else        { src = A.in[I_SOUT] + (size_t)a * DIN * DM; dst = (bf16*)(wl + WA_WOUT); gain = A.in[I_SNORM] + a * DIN; K = DIN; N = DM; }
        } else if (job < 32) { const int bb = (job - 28) / 2, k = (job - 28) % 2; unsigned char* wl = ws + WS_WB + (size_t)bb * WB_STRIDE;
            if (k == 0) { src = A.in[I_WQ] + (size_t)bb * DM * DM; dst = (bf16*)(wl + WB_WQ); gain = A.in[I_MIXN] + (2 + bb) * DM; K = DM; N = DM; }
            else        { src = A.in[I_WO] + (size_t)bb * DM * DM; dst = (bf16*)(wl + WB_WO); K = DM; N = DM; }
        } else { src = A.in[I_WKV]; dst = (bf16*)(ws + WS_WKV); gain = A.in[I_KVN]; K = DM; N = 512; }
        const int nitems = (K / 64) * (N / 32);
        for (int it = widx; it < nitems; it += 2 * nw) {
            const int it2 = it + nw; const bool two = it2 < nitems;
            float va[32], vb[32], ga, gb = 1.0f;
            tr_load(src, N, gain, it, lane, va, ga);
            if (two) tr_load(src, N, gain, it2, lane, vb, gb);
            tr_finish(va, ga, K, N, dst, mode, scr, it, lane);
            if (two) tr_finish(vb, gb, K, N, dst, mode, scr, it2, lane);
        }
    }
}
#define JB(j) (1ull << (j))
constexpr unsigned long long PROLOGUE_JOBS = JB(0) | JB(1) | JB(24);
__device__ __forceinline__ unsigned long long tail_jobs(int L, int s) {
    if (L == 0) return s == 0 ? (JB(25) | JB(2) | JB(3)) : (s == 2 ? (JB(4) | JB(5) | JB(26) | JB(27)) : (s == 6 ? (JB(6) | JB(7)) : 0ull));
    if (L == 1) return s == 0 ? (JB(8) | JB(9)) : (s == 2 ? (JB(10) | JB(11) | JB(28) | JB(29) | JB(32)) : (s == 6 ? (JB(12) | JB(13)) : 0ull));
    if (L == 2) return s == 0 ? (JB(14) | JB(15) | JB(16) | JB(17)) : (s == 6 ? (JB(18) | JB(19) | JB(30) | JB(31)) : 0ull);
    return s == 0 ? (JB(20) | JB(21) | JB(22) | JB(23)) : 0ull;
}

__device__ __forceinline__ void p0_prologue(const Args& A, LAS unsigned char* lds, int tid, int lane, int wave) {
    unsigned char* ws = A.ws;
    const int gw = blockIdx.x * 8 + wave, NGW = gridDim.x * 8;
    const int gt = blockIdx.x * 512 + tid, NGT = gridDim.x * 512;
    convert_weights(A, lds, lane, wave, PROLOGUE_JOBS, gw, NGW);
    for (int i = gt; i < 2 * (NINP - NIN) * DM / 8; i += NGT) { const int a = i / ((NINP - NIN) * DM / 8), r = i % ((NINP - NIN) * DM / 8);
        *(u32x4*)((bf16*)(ws + WS_WA + (size_t)a * WA_STRIDE + WA_WIN) + (size_t)NIN * DM + (size_t)r * 8) = (u32x4){0u, 0u, 0u, 0u}; }
    bf16* XB = (bf16*)(ws + WS_XB); float* SS = (float*)(ws + WS_SS);
    for (int m = gw; m < MPAD; m += NGW) {
        f32x4 v[4]; float s = 0.f;
        if (m < MR) { const float* xr = (m < MP) ? A.in[I_XP] + (size_t)m * DM : A.in[I_XS] + (size_t)(m - MP) * DM;
#pragma unroll
            for (int j = 0; j < 4; ++j) { v[j] = ((const f32x4*)xr)[lane + 64 * j]; s += (v[j][0] * v[j][0] + v[j][1] * v[j][1]) + (v[j][2] * v[j][2] + v[j][3] * v[j][3]); }
        } else {
#pragma unroll
            for (int j = 0; j < 4; ++j) v[j] = (f32x4){0.f, 0.f, 0.f, 0.f};
        }
        s = wave_sum(s);
#pragma unroll
        for (int j = 0; j < 4; ++j) {
            u32x2 w; w.x = cvt_pk_bf16(v[j][0], v[j][1]); w.y = cvt_pk_bf16(v[j][2], v[j][3]); ((u32x2*)(XB + (size_t)m * DM))[lane + 64 * j] = w; }
        if (lane < 16) SS[(size_t)m * 16 + lane] = (lane == 0) ? s : 0.f;
    }
    bf16* P16 = (bf16*)(ws + WS_P16);
    for (int r4 = gw; r4 < NLAYER * MPAD / 4; r4 += NGW) {
        f32x4 v[4];
#pragma unroll
        for (int q = 0; q < 4; ++q) { const int r = r4 * 4 + q, L = r / MPAD, m = r % MPAD; v[q] = (f32x4){0.f, 0.f, 0.f, 0.f};
            if (m < MP) v[q] = ((const f32x4*)(A.in[I_PP] + ((size_t)L * MP + m) * DPLE))[lane]; else if (m < MR) v[q] = ((const f32x4*)(A.in[I_PS] + ((size_t)L * MS + (m - MP)) * DPLE))[lane]; }
#pragma unroll
        for (int q = 0; q < 4; ++q) { u32x2 w; w.x = cvt_pk_bf16(v[q][0], v[q][1]); w.y = cvt_pk_bf16(v[q][2], v[q][3]); ((u32x2*)(P16 + (size_t)(r4 * 4 + q) * DPLE))[lane] = w; }
    }
    float* RT = (float*)(ws + WS_ROPE);
    for (int i = gt; i < 2049 * 32; i += NGT) { const int idx = i >> 5, fi = i & 31; const int pos = idx < SEQ ? idx : PAST;
        const float inv = (float)(ROPE_T8[fi & 7] * ROPE_P10[fi >> 3]); const float ang = (float)pos * inv;
        const double t = (double)ang * 0.15915494309189535; const float fr = (float)(t - rint(t));
        RT[2 * i] = __builtin_amdgcn_cosf(fr); RT[2 * i + 1] = __builtin_amdgcn_sinf(fr); }
    for (int i = gt; i < MS * 127 * 64; i += NGT) { const int b = i / (127 * 64), r = i % (127 * 64);
        ((f32x4*)(A.out + O_KS + (size_t)b * 128 * 256))[r] = ((const f32x4*)(A.in[I_CK] + (size_t)b * 128 * 256 + 256))[r];
        ((f32x4*)(A.out + O_VS + (size_t)b * 128 * 256))[r] = ((const f32x4*)(A.in[I_CV] + (size_t)b * 128 * 256 + 256))[r]; }
}

constexpr int SRS = 272;
constexpr int L_C = 0, L_B = 128 * SRS, L_BW = 2 * 128 * SRS, L_XT = 3 * 128 * SRS, L_HS = L_XT + 64 * SRS, L_CUM = L_HS + 64 * SRS, L_DTV = L_CUM + 512, L_SSD_END = L_DTV + 512;
static_assert(L_SSD_END <= LDS_BYTES, "ssd lds");
__device__ __forceinline__ float softplus_f(float x) { return x > 20.f ? x : log1pf(__expf(x)); }
__device__ __forceinline__ f32x16 mfma32(bf16x8 a, bf16x8 b, f32x16 c) { return __builtin_amdgcn_mfma_f32_32x32x16_bf16(a, b, c, 0, 0, 0); }
__device__ __forceinline__ void unpack8(u32x4 w, float (&f)[8]) { f[0] = bflo(w.x); f[1] = bfhi(w.x); f[2] = bflo(w.y); f[3] = bfhi(w.y); f[4] = bflo(w.z); f[5] = bfhi(w.z); f[6] = bflo(w.w); f[7] = bfhi(w.w); }

__device__ __forceinline__ void ssd_prompt_unit(const Args& A, LAS unsigned char* lds, int layer, int b, int h, int tid, int lane, int wid) {
    unsigned char* ws = A.ws;
    const bf16* XBC = (const bf16*)(ws + WS_XBC); const bf16* Z = (const bf16*)(ws + WS_Z); bf16* YG = (bf16*)(ws + WS_YG); const bf16* BCA = (const bf16*)(ws + WS_H);
    const float* DT = (const float*)(ws + WS_DT); float* GSQ = (float*)(ws + WS_GSQ);
    const int hi = lane >> 5, l32 = lane & 31, g = h >> 2;
    const float a_h = -__expf(A.in[I_SALOG][layer * NH + h]), dtb = A.in[I_SDTB][layer * NH + h], Dh = A.in[I_SD][layer * NH + h];
    LAS float* cum_s = (LAS float*)(lds + L_CUM); LAS float* dt_s = (LAS float*)(lds + L_DTV);
    f32x16 hacc;
#pragma unroll
    for (int r = 0; r < 16; ++r) hacc[r] = 0.f;
    for (int i = tid; i < 64 * SRS / 16; i += 512) *(LAS u32x4*)(lds + L_HS + i * 16) = (u32x4){0u, 0u, 0u, 0u};
    __syncthreads();
    float dtn = 0.f, dtn0 = 0.f;
    if (wid < 2) { dtn = DT[(size_t)(b * SEQ + tid) * 32 + h]; dtn0 = DT[(size_t)(b * SEQ + lane) * 32 + h]; }
    for (int c = 0; c < 16; ++c) {
        const int row0 = b * SEQ + c * 128;
        if (wid < 2) {
            const float dtv = softplus_f(dtn + dtb); float v = dtv * a_h;
#pragma unroll
            for (int o = 1; o < 64; o <<= 1) { const float t = __shfl_up(v, o); if (lane >= o) v += t; }
            if (wid == 1) { const float d0 = softplus_f(dtn0 + dtb) * a_h; v += wave_sum(d0); }
            cum_s[tid] = v; dt_s[tid] = dtv;
            if (c < 15) { dtn = DT[(size_t)(row0 + 128 + tid) * 32 + h]; dtn0 = DT[(size_t)(row0 + 128 + lane) * 32 + h]; }
        }
        __syncthreads();
        if (wid < 4) {
            const int oct = tid & 7, seg = tid >> 3, l0 = seg * 4, t0 = c * 128 + l0, chx = h * 64 + oct * 8;
            float cw[4][8], cb[8];
            {
                const float* cwp = A.in[I_SCW] + (size_t)layer * 4 * CONVD + chx; const float* cbp = A.in[I_SCB] + (size_t)layer * CONVD + chx;
#pragma unroll
                for (int k = 0; k < 4; ++k) { const f32x4 w0 = *(const f32x4*)(cwp + k * CONVD), w1 = *(const f32x4*)(cwp + k * CONVD + 4);
#pragma unroll
                    for (int e = 0; e < 4; ++e) { cw[k][e] = w0[e]; cw[k][4 + e] = w1[e]; } }
                const f32x4 b0 = *(const f32x4*)cbp, b1 = *(const f32x4*)(cbp + 4);
#pragma unroll
                for (int e = 0; e < 4; ++e) { cb[e] = b0[e]; cb[4 + e] = b1[e]; }
            }
            const bf16* src = XBC + (size_t)(b * SEQ + t0) * CONVD + chx;
            u32x4 rw[7];
#pragma unroll
            for (int j = 0; j < 7; ++j) { if (j < 3 && t0 < 3) rw[j] = (u32x4){0u, 0u, 0u, 0u}; else rw[j] = *(const u32x4*)(src + (j - 3) * CONVD); }
            float r0[8], r1[8], r2[8]; unpack8(rw[0], r0); unpack8(rw[1], r1); unpack8(rw[2], r2);
            unsigned tp[8][2];
#pragma unroll
            for (int i2 = 0; i2 < 2; ++i2) {
                float na[8], nb2[8]; unpack8(rw[3 + 2 * i2], na); unpack8(rw[4 + 2 * i2], nb2);
#pragma unroll
                for (int e = 0; e < 8; ++e) {
                    const float va = cb[e] + cw[0][e] * r0[e] + cw[1][e] * r1[e] + cw[2][e] * r2[e] + cw[3][e] * na[e];
                    const float vb = cb[e] + cw[0][e] * r1[e] + cw[1][e] * r2[e] + cw[2][e] * na[e] + cw[3][e] * nb2[e];
                    tp[e][i2] = cvt_pk_bf16(silu_f(va), silu_f(vb));
                    r0[e] = r2[e]; r1[e] = na[e]; r2[e] = nb2[e];
                }
            }
#pragma unroll
            for (int e = 0; e < 8; ++e) *(LAS u32x2*)(lds + L_XT + (oct * 8 + e) * SRS + l0 * 2) = (u32x2){tp[e][0], tp[e][1]};
        } else if (wid < 6) {
            const int t = tid - 256, oct = t & 15, l0 = (t >> 4) * 16; const float cl = cum_s[127];
            const bf16* src = BCA + (size_t)(row0 + l0) * 2048 + g * 128 + oct * 8;
#pragma unroll 2
            for (int hf = 0; hf < 4; ++hf) {
                u32x4 rw[4]; float f[4][8], sc[4];
#pragma unroll
                for (int j = 0; j < 4; ++j) rw[j] = *(const u32x4*)(src + (size_t)(4 * hf + j) * 2048);
#pragma unroll
                for (int j = 0; j < 4; ++j) { const int l = l0 + 4 * hf + j; *(LAS u32x4*)(lds + L_B + l * SRS + oct * 16) = rw[j]; unpack8(rw[j], f[j]); sc[j] = dt_s[l] * __expf(cl - cum_s[l]); }
#pragma unroll
                for (int e = 0; e < 8; ++e) *(LAS u32x2*)(lds + L_BW + (oct * 8 + e) * SRS + (l0 + 4 * hf) * 2) = (u32x2){cvt_pk_bf16(f[0][e] * sc[0], f[1][e] * sc[1]), cvt_pk_bf16(f[2][e] * sc[2], f[3][e] * sc[3])};
            }
        } else {
            const int t = tid - 384, oct = t & 15, l0 = (t >> 4) * 16;
            const bf16* src = BCA + (size_t)(row0 + l0) * 2048 + 1024 + g * 128 + oct * 8;
#pragma unroll 8
            for (int j = 0; j < 16; ++j) *(LAS u32x4*)(lds + L_C + (l0 + j) * SRS + oct * 16) = *(const u32x4*)(src + (size_t)j * 2048);
        }
        __syncthreads();
        u32x2 zpre[4];
        {
            const int pb = wid & 1, lb = wid >> 1; const size_t zrow = (size_t)row0 + 32 * lb + l32;
#pragma unroll
            for (int rq = 0; rq < 4; ++rq) zpre[rq] = *(const u32x2*)(Z + zrow * DIN + h * 64 + 32 * pb + 8 * rq + 4 * hi);
        }
        {
            const int lb = wid >> 1;
            f32x16 cacc[2];
#pragma unroll
            for (int t = 0; t < 2; ++t) {
#pragma unroll
                for (int r = 0; r < 16; ++r) cacc[t][r] = 0.f;
                const int sb = 2 * (wid & 1) + t;
                if (sb <= lb) {
#pragma unroll
                    for (int ks = 0; ks < 8; ++ks) {
                        const bf16x8 av = *(const LAS bf16x8*)(lds + L_B + (32 * sb + l32) * SRS + (16 * ks + 8 * hi) * 2);
                        const bf16x8 bv = *(const LAS bf16x8*)(lds + L_C + (32 * lb + l32) * SRS + (16 * ks + 8 * hi) * 2);
                        cacc[t] = mfma32(av, bv, cacc[t]);
                    }
                }
            }
            __syncthreads();
            const int l = 32 * lb + l32; const float cll = cum_s[l];
#pragma unroll
            for (int t = 0; t < 2; ++t) {
                const int sb = 2 * (wid & 1) + t;
                if (sb <= lb) {
#pragma unroll
                    for (int rq = 0; rq < 4; ++rq) {
                        const int s0 = 32 * sb + 8 * rq + 4 * hi; float v[4];
#pragma unroll
                        for (int e = 0; e < 4; ++e) { const int s = s0 + e; float x = cacc[t][4 * rq + e] * __expf(cll - cum_s[s]) * dt_s[s]; x = (s > l) ? 0.f : x; x = (s == l) ? x + Dh : x; v[e] = x; }
                        u32x2 w; w.x = cvt_pk_bf16(v[0], v[1]); w.y = cvt_pk_bf16(v[2], v[3]);
                        *(LAS u32x2*)(lds + L_B + l * SRS + s0 * 2) = w;
                    }
                }
            }
        }
        __syncthreads();
        {
            const int pb = wid & 1, lb = wid >> 1;
            f32x16 yacc;
#pragma unroll
            for (int r = 0; r < 16; ++r) yacc[r] = 0.f;
#pragma unroll
            for (int ks = 0; ks < 8; ++ks) {
                const bf16x8 av = *(const LAS bf16x8*)(lds + L_HS + (32 * pb + l32) * SRS + (16 * ks + 8 * hi) * 2);
                const bf16x8 bv = *(const LAS bf16x8*)(lds + L_C + (32 * lb + l32) * SRS + (16 * ks + 8 * hi) * 2);
                yacc = mfma32(av, bv, yacc);
            }
            const float el = __expf(cum_s[32 * lb + l32]);
#pragma unroll
            for (int r = 0; r < 16; ++r) yacc[r] *= el;
            for (int sb = 0; sb <= lb; ++sb) {
#pragma unroll
                for (int k2 = 0; k2 < 2; ++k2) {
                    const bf16x8 av = *(const LAS bf16x8*)(lds + L_XT + (32 * pb + l32) * SRS + (32 * sb + 16 * k2 + 8 * hi) * 2);
                    const bf16x8 bv = *(const LAS bf16x8*)(lds + L_B + (32 * lb + l32) * SRS + (32 * sb + 16 * k2 + 8 * hi) * 2);
                    yacc = mfma32(av, bv, yacc);
                }
            }
            const size_t row = (size_t)row0 + 32 * lb + l32; float sq = 0.f;
#pragma unroll
            for (int rq = 0; rq < 4; ++rq) {
                const int p0 = 32 * pb + 8 * rq + 4 * hi; const u32x2 zz = zpre[rq];
                const float g0 = yacc[4 * rq + 0] * silu_f(bflo(zz.x)), g1 = yacc[4 * rq + 1] * silu_f(bfhi(zz.x)), g2 = yacc[4 * rq + 2] * silu_f(bflo(zz.y)), g3 = yacc[4 * rq + 3] * silu_f(bfhi(zz.y));
                sq += (g0 * g0 + g1 * g1) + (g2 * g2 + g3 * g3);
                u32x2 w; w.x = cvt_pk_bf16(g0, g1); w.y = cvt_pk_bf16(g2, g3); *(u32x2*)(YG + row * DIN + h * 64 + p0) = w;
            }
            sq += __shfl_xor(sq, 32);
            if (hi == 0) GSQ[row * 64 + 2 * h + pb] = sq;
        }
        const int nb = wid & 3, pb2 = wid >> 2;
        {
            const float dl = __expf(cum_s[127]);
#pragma unroll
            for (int r = 0; r < 16; ++r) hacc[r] *= dl;
#pragma unroll
            for (int ks = 0; ks < 8; ++ks) {
                const bf16x8 av = *(const LAS bf16x8*)(lds + L_BW + (32 * nb + l32) * SRS + (16 * ks + 8 * hi) * 2);
                const bf16x8 bv = *(const LAS bf16x8*)(lds + L_XT + (32 * pb2 + l32) * SRS + (16 * ks + 8 * hi) * 2);
                hacc = mfma32(av, bv, hacc);
            }
        }
        __syncthreads();
        {
            const int p = 32 * pb2 + l32;
#pragma unroll
            for (int rq = 0; rq < 4; ++rq) { const int n0 = 32 * nb + 8 * rq + 4 * hi; u32x2 w; w.x = cvt_pk_bf16(hacc[4 * rq], hacc[4 * rq + 1]); w.y = cvt_pk_bf16(hacc[4 * rq + 2], hacc[4 * rq + 3]);
                *(LAS u32x2*)(lds + L_HS + p * SRS + n0 * 2) = w; }
        }
    }
    int lane2 = lane; asm volatile("" : "+v"(lane2));
    {
        const int hi = lane2 >> 5, l32 = lane2 & 31;
        const int nb = wid & 3, pb2 = wid >> 2, p = 32 * pb2 + l32;
        float* o = A.out + O_SSMP + (((size_t)(layer * NB + b) * NH + h) * 64 + p) * DST;
#pragma unroll
        for (int rq = 0; rq < 4; ++rq) { const int n0 = 32 * nb + 8 * rq + 4 * hi; *(f32x4*)(o + n0) = (f32x4){hacc[4 * rq], hacc[4 * rq + 1], hacc[4 * rq + 2], hacc[4 * rq + 3]}; }
    }
    const int tid2 = wid * 64 + lane2;
    if (tid2 < 384) { const int k = tid2 >> 7, j = tid2 & 127, chn = h * 128 + j;
        A.out[O_CONVP + ((size_t)(layer * NB + b) * 3 + k) * CONVD + chn] = bf1(XBC[(size_t)(b * SEQ + SEQ - 3 + k) * CONVD + chn]); }
    __syncthreads();
}

__device__ __forceinline__ void ssd_sample_item(const Args& A, int layer, int b, int h, int lane) {
    unsigned char* ws = A.ws;
    const bf16* XBC = (const bf16*)(ws + WS_XBC); const bf16* Z = (const bf16*)(ws + WS_Z); bf16* YG = (bf16*)(ws + WS_YG);
    const float* DT = (const float*)(ws + WS_DT); float* GSQ = (float*)(ws + WS_GSQ);
    const int g = h >> 2, psub = lane >> 4, nch = lane & 15, n0 = 8 * nch; const size_t row = (size_t)MP + b;
    const float* cwp = A.in[I_SCW] + (size_t)layer * 4 * CONVD; const float* cbp = A.in[I_SCB] + (size_t)layer * CONVD;
    const float* c0 = A.in[I_CONV] + ((size_t)layer * MS + b) * 3 * CONVD;
    float Bv[8], Cv[8];
    {
        const int chB = DIN + g * 128 + n0, chC = DIN + 1024 + g * 128 + n0;
        float nB[8], nC[8]; unpack8(*(const u32x4*)(XBC + row * CONVD + chB), nB); unpack8(*(const u32x4*)(XBC + row * CONVD + chC), nC);
#pragma unroll
        for (int e = 0; e < 8; ++e) {
            float vb = cbp[chB + e] + cwp[3 * CONVD + chB + e] * nB[e], vc = cbp[chC + e] + cwp[3 * CONVD + chC + e] * nC[e];
#pragma unroll
            for (int k = 0; k < 3; ++k) { vb += cwp[k * CONVD + chB + e] * c0[k * CONVD + chB + e]; vc += cwp[k * CONVD + chC + e] * c0[k * CONVD + chC + e]; }
            Bv[e] = silu_f(vb); Cv[e] = silu_f(vc);
        }
    }
    float xact;
    { const int chx = h * 64 + lane; float v = cbp[chx] + cwp[3 * CONVD + chx] * bf1(XBC[row * CONVD + chx]);
#pragma unroll
      for (int k = 0; k < 3; ++k) v += cwp[k * CONVD + chx] * c0[k * CONVD + chx];
      xact = silu_f(v); }
    const float a_h = -__expf(A.in[I_SALOG][layer * NH + h]), Dh = A.in[I_SD][layer * NH + h];
    const float dtv = softplus_f(DT[row * 32 + h] + A.in[I_SDTB][layer * NH + h]); const float dec = __expf(dtv * a_h);
    const float* h0 = A.in[I_SSM] + (((size_t)layer * MS + b) * NH + h) * 64 * DST; float* h1 = A.out + O_SSMS + (((size_t)layer * MS + b) * NH + h) * 64 * DST;
    float sq = 0.f;
#pragma unroll 4
    for (int it = 0; it < 16; ++it) {
        const int p = 4 * it + psub; const float xp = __shfl(xact, p); const float xd = xp * dtv;
        const f32x4 a0 = *(const f32x4*)(h0 + p * DST + n0), a1 = *(const f32x4*)(h0 + p * DST + n0 + 4);
        f32x4 o0, o1; float yp = 0.f;
#pragma unroll
        for (int e = 0; e < 4; ++e) { o0[e] = dec * a0[e] + xd * Bv[e]; o1[e] = dec * a1[e] + xd * Bv[4 + e]; yp += o0[e] * Cv[e] + o1[e] * Cv[4 + e]; }
        *(f32x4*)(h1 + p * DST + n0) = o0; *(f32x4*)(h1 + p * DST + n0 + 4) = o1;
        yp += __shfl_xor(yp, 1); yp += __shfl_xor(yp, 2); yp += __shfl_xor(yp, 4); yp += __shfl_xor(yp, 8);
        if (nch == 0) { const float y = yp + Dh * xp; const float gt = y * silu_f(bf1(Z[row * DIN + h * 64 + p])); sq += gt * gt; YG[row * DIN + h * 64 + p] = f2bf(gt); }
    }
    sq += __shfl_xor(sq, 16); sq += __shfl_xor(sq, 32);
    if (lane == 0) { GSQ[row * 64 + 2 * h] = sq; GSQ[row * 64 + 2 * h + 1] = 0.f; }
}

__device__ __forceinline__ void ssd_pre_phase(const Args& A, int layer, int tid, int lane, int wid) {
    const bf16* XBC = (const bf16*)(A.ws + WS_XBC); bf16* BCA = (bf16*)(A.ws + WS_H);
    for (int task = blockIdx.x * 512 + tid; task < 256 * (MP / 32); task += gridDim.x * 512) {
        const int oct = task & 255, m0 = (task >> 8) * 32, t0 = m0 % SEQ, chn = DIN + oct * 8;
        float cw[4][8], cb[8];
        {
            const float* cwp = A.in[I_SCW] + (size_t)layer * 4 * CONVD + chn; const float* cbp = A.in[I_SCB] + (size_t)layer * CONVD + chn;
#pragma unroll
            for (int k = 0; k < 4; ++k) { const f32x4 w0 = *(const f32x4*)(cwp + k * CONVD), w1 = *(const f32x4*)(cwp + k * CONVD + 4);
#pragma unroll
                for (int e = 0; e < 4; ++e) { cw[k][e] = w0[e]; cw[k][4 + e] = w1[e]; } }
            const f32x4 b0 = *(const f32x4*)cbp, b1 = *(const f32x4*)(cbp + 4);
#pragma unroll
            for (int e = 0; e < 4; ++e) { cb[e] = b0[e]; cb[4 + e] = b1[e]; }
        }
        const bf16* src = XBC + (size_t)m0 * CONVD + chn; bf16* dst = BCA + (size_t)m0 * 2048 + oct * 8;
        float r0[8], r1[8], r2[8];
        if (t0 >= 3) { unpack8(*(const u32x4*)(src - 3 * CONVD), r0); unpack8(*(const u32x4*)(src - 2 * CONVD), r1); unpack8(*(const u32x4*)(src - 1 * CONVD), r2); }
        else {
#pragma unroll
            for (int e = 0; e < 8; ++e) { r0[e] = 0.f; r1[e] = 0.f; r2[e] = 0.f; }
        }
#pragma unroll 1
        for (int i8 = 0; i8 < 4; ++i8) {
            u32x4 rw[8];
#pragma unroll
            for (int j = 0; j < 8; ++j) rw[j] = *(const u32x4*)(src + (size_t)(8 * i8 + j) * CONVD);
#pragma unroll
            for (int j = 0; j < 8; ++j) {
                float na[8], aa[8]; unpack8(rw[j], na);
#pragma unroll
                for (int e = 0; e < 8; ++e) { aa[e] = silu_f(cb[e] + cw[0][e] * r0[e] + cw[1][e] * r1[e] + cw[2][e] * r2[e] + cw[3][e] * na[e]); r0[e] = r1[e]; r1[e] = r2[e]; r2[e] = na[e]; }
                u32x4 w; w.x = cvt_pk_bf16(aa[0], aa[1]); w.y = cvt_pk_bf16(aa[2], aa[3]); w.z = cvt_pk_bf16(aa[4], aa[5]); w.w = cvt_pk_bf16(aa[6], aa[7]);
                *(u32x4*)(dst + (size_t)(8 * i8 + j) * 2048) = w;
            }
        }
    }
    for (int it = blockIdx.x * 8 + wid; it < MS * NH; it += gridDim.x * 8) ssd_sample_item(A, layer, it / NH, it % NH, lane);
    for (int i = blockIdx.x * 512 + tid; i < MS * 3 * CONVD; i += gridDim.x * 512) { const int b = i / (3 * CONVD), r = i % (3 * CONVD), k = r / CONVD, chn = r % CONVD;
        A.out[O_CONVS + (size_t)layer * MS * 3 * CONVD + i] = (k < 2) ? A.in[I_CONV][((size_t)layer * MS + b) * 3 * CONVD + (k + 1) * CONVD + chn] : bf1(XBC[(size_t)(MP + b) * CONVD + chn]); }
}
__device__ __forceinline__ void ssd_phase(const Args& A, LAS unsigned char* lds, int layer, int tid, int lane, int wid) {
    for (int u = blockIdx.x; u < NB * NH; u += gridDim.x) ssd_prompt_unit(A, lds, layer, u / NH, u % NH, tid, lane, wid);
}
__device__ __forceinline__ void gnorm_phase(const Args& A, int tid) {
    bf16* YG = (bf16*)(A.ws + WS_YG); const float* GSQ = (const float*)(A.ws + WS_GSQ);
    for (int i = blockIdx.x * 512 + tid; i < MR * 256; i += gridDim.x * 512) { const int m = i >> 8, c8 = i & 255, g = c8 >> 5;
        const f32x4 s0 = *(const f32x4*)(GSQ + (size_t)m * 64 + g * 8), s1 = *(const f32x4*)(GSQ + (size_t)m * 64 + g * 8 + 4);
        const float s = ((s0[0] + s0[1]) + (s0[2] + s0[3])) + ((s1[0] + s1[1]) + (s1[2] + s1[3])); const float rs = __builtin_amdgcn_rsqf(s * (1.0f / 256.0f) + 1e-6f);
        u32x4* p = (u32x4*)(YG + (size_t)m * DIN + c8 * 8); const u32x4 w = *p; float f[8]; unpack8(w, f);
        u32x4 o; o.x = cvt_pk_bf16(f[0] * rs, f[1] * rs); o.y = cvt_pk_bf16(f[2] * rs, f[3] * rs); o.z = cvt_pk_bf16(f[4] * rs, f[5] * rs); o.w = cvt_pk_bf16(f[6] * rs, f[7] * rs); *p = o; }
}

__device__ __forceinline__ void kv_finalize(const Args& A, int lane, int wid) {
    unsigned char* ws = A.ws; const float* KV = (const float*)(ws + WS_KVRAW); const float* RT = (const float*)(ws + WS_ROPE);
    bf16* KF = (bf16*)(ws + WS_KF); bf16* VT = (bf16*)(ws + WS_VT);
    const int kvh = lane >> 4, j = lane & 15;
    const float gn0 = A.in[I_KN][2 * j], gn1 = A.in[I_KN][2 * j + 1], gn2 = A.in[I_KN][2 * j + 32], gn3 = A.in[I_KN][2 * j + 33];
    for (int m = blockIdx.x * 8 + wid; m < MR; m += gridDim.x * 8) {
        const float* kr = KV + (size_t)m * 512 + kvh * 64; const float* vr = kr + 256;
        float x10 = kr[2 * j], x11 = kr[2 * j + 1], x20 = kr[2 * j + 32], x21 = kr[2 * j + 33];
        float ss = (x10 * x10 + x11 * x11) + (x20 * x20 + x21 * x21);
        ss += __shfl_xor(ss, 1); ss += __shfl_xor(ss, 2); ss += __shfl_xor(ss, 4); ss += __shfl_xor(ss, 8);
        const float rs = __builtin_amdgcn_rsqf(ss * (1.0f / 64.0f) + 1e-6f);
        x10 *= rs * gn0; x11 *= rs * gn1; x20 *= rs * gn2; x21 *= rs * gn3;
        const int pidx = m < MP ? (m % SEQ) : SEQ;
        const f32x4 cs = *(const f32x4*)(RT + ((size_t)pidx * 32 + 2 * j) * 2);
        const float o10 = x10 * cs[0] - x20 * cs[1], o20 = x20 * cs[0] + x10 * cs[1], o11 = x11 * cs[2] - x21 * cs[3], o21 = x21 * cs[2] + x11 * cs[3];
        const f32x4 v4 = *(const f32x4*)(vr + 4 * j);
        if (m < MP) {
            const int b = m / SEQ, t = m % SEQ; const size_t bk = (size_t)b * 4 + kvh;
            bf16* kd = KF + (bk * SEQ + t) * 64;
            *(unsigned*)(kd + 2 * j) = cvt_pk_bf16(o10, o11); *(unsigned*)(kd + 2 * j + 32) = cvt_pk_bf16(o20, o21);
            bf16* vd = VT + ((bk * 64 + (t >> 5)) * 64 + 4 * j) * 32 + (t & 31);
            vd[0] = f2bf(v4[0]); vd[32] = f2bf(v4[1]); vd[64] = f2bf(v4[2]); vd[96] = f2bf(v4[3]);
            if (t >= SEQ - 128) { float* ko = A.out + O_KP + (((size_t)b * 128 + (t - (SEQ - 128))) * 4 + kvh) * 64; float* vo = A.out + O_VP + (((size_t)b * 128 + (t - (SEQ - 128))) * 4 + kvh) * 64;
                ko[2 * j] = o10; ko[2 * j + 1] = o11; ko[2 * j + 32] = o20; ko[2 * j + 33] = o21; *(f32x4*)(vo + 4 * j) = v4; }
        } else {
            const int b = m - MP; float* ko = A.out + O_KS + (((size_t)b * 128 + 127) * 4 + kvh) * 64; float* vo = A.out + O_VS + (((size_t)b * 128 + 127) * 4 + kvh) * 64;
            ko[2 * j] = o10; ko[2 * j + 1] = o11; ko[2 * j + 32] = o20; ko[2 * j + 33] = o21; *(f32x4*)(vo + 4 * j) = v4;
        }
    }
}

constexpr int KRS = 144, VRS = 80, L_AK = 0, L_AV = 256 * KRS;
__device__ __forceinline__ void attn_prompt_tile(const Args& A, LAS unsigned char* lds, int lt0, int jl, int b, int hq, int r0, int lane) {
    unsigned char* ws = A.ws; const bf16* Q = (const bf16*)(ws + WS_Q); bf16* O = (bf16*)(ws + WS_O); const float* RT = (const float*)(ws + WS_ROPE);
    const bf16* KF = (const bf16*)(ws + WS_KF); const bf16* VT = (const bf16*)(ws + WS_VT);
    const int hi = lane >> 5, l32 = lane & 31, kvh = hq >> 2; const size_t bk = (size_t)b * 4 + kvh;
    const int qp = r0 + l32; const size_t qrow = (size_t)b * SEQ + qp;
    bf16x8 qf[4];
    {
        float qv[4][8]; float ss = 0.f;
#pragma unroll
        for (int ks = 0; ks < 4; ++ks) { unpack8(*(const u32x4*)(Q + qrow * DM + hq * 64 + 16 * ks + 8 * hi), qv[ks]);
#pragma unroll
            for (int e = 0; e < 8; ++e) ss += qv[ks][e] * qv[ks][e]; }
        ss += __shfl_xor(ss, 32);
        const float rs = __builtin_amdgcn_rsqf(ss * (1.0f / 64.0f) + 1e-6f) * 0.125f;
        const float* qn = A.in[I_QN] + jl * 64;
#pragma unroll
        for (int ks = 0; ks < 2; ++ks) {
            float o1[8], o2[8];
#pragma unroll
            for (int e = 0; e < 8; ++e) { const int i = 16 * ks + 8 * hi + e; const float x1 = qv[ks][e] * rs * qn[i], x2 = qv[ks + 2][e] * rs * qn[i + 32];
                const float cs = RT[((size_t)qp * 32 + i) * 2], sn = RT[((size_t)qp * 32 + i) * 2 + 1]; o1[e] = x1 * cs - x2 * sn; o2[e] = x2 * cs + x1 * sn; }
            u32x4 w; w.x = cvt_pk_bf16(o1[0], o1[1]); w.y = cvt_pk_bf16(o1[2], o1[3]); w.z = cvt_pk_bf16(o1[4], o1[5]); w.w = cvt_pk_bf16(o1[6], o1[7]); qf[ks] = __builtin_bit_cast(bf16x8, w);
            w.x = cvt_pk_bf16(o2[0], o2[1]); w.y = cvt_pk_bf16(o2[2], o2[3]); w.z = cvt_pk_bf16(o2[4], o2[5]); w.w = cvt_pk_bf16(o2[6], o2[7]); qf[ks + 2] = __builtin_bit_cast(bf16x8, w);
        }
    }
    f32x16 s[5];
    const float NEG = -1e30f;
#pragma unroll
    for (int kt = 0; kt < 5; ++kt) {
        const int k0 = r0 - 128 + 32 * kt;
#pragma unroll
        for (int r = 0; r < 16; ++r) s[kt][r] = 0.f;
        if (k0 >= 0) {
#pragma unroll
            for (int ks = 0; ks < 4; ++ks) { const bf16x8 kf = *(const LAS bf16x8*)(lds + L_AK + (32 * (lt0 + kt) + l32) * KRS + (16 * ks + 8 * hi) * 2); s[kt] = mfma32(kf, qf[ks], s[kt]); }
        }
    }
    const float sink = A.in[I_SINK][jl * 16 + hq];
    float mx = sink;
#pragma unroll
    for (int kt = 0; kt < 5; ++kt) {
        const int k0 = r0 - 128 + 32 * kt;
#pragma unroll
        for (int r = 0; r < 16; ++r) { const int kp = k0 + (r & 3) + 8 * (r >> 2) + 4 * hi; const bool ok = (kp >= 0) && (kp <= qp) && (qp - kp <= 128);
            s[kt][r] = ok ? s[kt][r] : NEG; mx = fmaxf(mx, s[kt][r]); }
    }
    mx = fmaxf(mx, __shfl_xor(mx, 32));
    float sum = 0.f;
#pragma unroll
    for (int kt = 0; kt < 5; ++kt)
#pragma unroll
        for (int r = 0; r < 16; ++r) { const float p = __expf(s[kt][r] - mx); s[kt][r] = p; sum += p; }
    sum += __shfl_xor(sum, 32);
    sum += __expf(sink - mx);
    f32x16 oacc[2];
#pragma unroll
    for (int dt = 0; dt < 2; ++dt)
#pragma unroll
        for (int r = 0; r < 16; ++r) oacc[dt][r] = 0.f;
#pragma unroll
    for (int kt = 0; kt < 5; ++kt) {
        const int k0 = r0 - 128 + 32 * kt;
        if (k0 >= 0) {
#pragma unroll
            for (int k2 = 0; k2 < 2; ++k2) {
                u32x4 pw; pw.x = cvt_pk_bf16(s[kt][8 * k2], s[kt][8 * k2 + 1]); pw.y = cvt_pk_bf16(s[kt][8 * k2 + 2], s[kt][8 * k2 + 3]); pw.z = cvt_pk_bf16(s[kt][8 * k2 + 4], s[kt][8 * k2 + 5]); pw.w = cvt_pk_bf16(s[kt][8 * k2 + 6], s[kt][8 * k2 + 7]);
                const bf16x8 pf = __builtin_bit_cast(bf16x8, pw);
#pragma unroll
                for (int dt = 0; dt < 2; ++dt) {
                    const LAS unsigned char* vp = lds + L_AV + ((lt0 + kt) * 64 + 32 * dt + l32) * VRS + (16 * k2 + 4 * hi) * 2;
                    const u32x2 v0 = *(const LAS u32x2*)vp, v1 = *(const LAS u32x2*)(vp + 16);
                    const bf16x8 vf = __builtin_bit_cast(bf16x8, ((u32x4){v0.x, v0.y, v1.x, v1.y}));
                    oacc[dt] = mfma32(vf, pf, oacc[dt]);
                }
            }
        }
    }
    const float inv = __builtin_amdgcn_rcpf(sum);
#pragma unroll
    for (int dt = 0; dt < 2; ++dt)
#pragma unroll
        for (int rq = 0; rq < 4; ++rq) { const int d0 = 32 * dt + 8 * rq + 4 * hi; u32x2 w; w.x = cvt_pk_bf16(oacc[dt][4 * rq] * inv, oacc[dt][4 * rq + 1] * inv); w.y = cvt_pk_bf16(oacc[dt][4 * rq + 2] * inv, oacc[dt][4 * rq + 3] * inv);
            *(u32x2*)(O + qrow * DM + hq * 64 + d0) = w; }
}
__device__ __forceinline__ void attn_sample_item(const Args& A, int jl, int b, int hq, int lane) {
    unsigned char* ws = A.ws; const bf16* Q = (const bf16*)(ws + WS_Q); bf16* O = (bf16*)(ws + WS_O); const float* RT = (const float*)(ws + WS_ROPE);
    const int kvh = hq >> 2; const size_t row = (size_t)MP + b;
    float qv = bf1(Q[row * DM + hq * 64 + lane]);
    const float ss = wave_sum(qv * qv); qv *= __builtin_amdgcn_rsqf(ss * (1.0f / 64.0f) + 1e-6f) * A.in[I_QN][jl * 64 + lane];
    const float other = __shfl_xor(qv, 32); const int i32 = lane & 31; const float cs = RT[((size_t)SEQ * 32 + i32) * 2], sn = RT[((size_t)SEQ * 32 + i32) * 2 + 1];
    const float qr = ((lane < 32) ? (qv * cs - other * sn) : (qv * cs + other * sn)) * 0.125f;
    const int dq = lane & 15, kg = lane >> 4;
    f32x4 q4;
#pragma unroll
    for (int e = 0; e < 4; ++e) q4[e] = __shfl(qr, 4 * dq + e);
    const float* ck = A.in[I_CK] + (size_t)b * 128 * 256 + kvh * 64 + 4 * dq; const float* kn = A.out + O_KS + ((size_t)b * 128 + 127) * 256 + kvh * 64 + 4 * dq;
    const float* cv = A.in[I_CV] + (size_t)b * 128 * 256 + kvh * 64 + 4 * dq; const float* vn = A.out + O_VS + ((size_t)b * 128 + 127) * 256 + kvh * 64 + 4 * dq;
    float sc[33];
#pragma unroll
    for (int i = 0; i < 33; ++i) { const int j = 4 * i + kg; float a = 0.f;
        if (j <= 128) { const f32x4 k4 = *(const f32x4*)((j < 128) ? ck + (size_t)j * 256 : kn); a = (k4[0] * q4[0] + k4[1] * q4[1]) + (k4[2] * q4[2] + k4[3] * q4[3]); }
        sc[i] = a;
        if (i % 11 == 10) asm volatile("" ::: "memory"); }
    const float sink = A.in[I_SINK][jl * 16 + hq];
    float mx = sink;
#pragma unroll
    for (int i = 0; i < 33; ++i) { float a = sc[i]; a += __shfl_xor(a, 1); a += __shfl_xor(a, 2); a += __shfl_xor(a, 4); a += __shfl_xor(a, 8);
        a = (4 * i + kg <= 128) ? a : -1e30f; sc[i] = a; mx = fmaxf(mx, a); }
    mx = fmaxf(mx, __shfl_xor(mx, 16)); mx = fmaxf(mx, __shfl_xor(mx, 32));
    float sum = 0.f;
#pragma unroll
    for (int i = 0; i < 33; ++i) { const float p = __expf(sc[i] - mx); sc[i] = p; sum += p; }
    sum += __shfl_xor(sum, 16); sum += __shfl_xor(sum, 32);
    sum += __expf(sink - mx);
    f32x4 o4 = (f32x4){0.f, 0.f, 0.f, 0.f};
#pragma unroll
    for (int i = 0; i < 33; ++i) { const int j = 4 * i + kg;
        if (j <= 128) { const f32x4 v4 = *(const f32x4*)((j < 128) ? cv + (size_t)j * 256 : vn); o4 += v4 * sc[i]; }
        if (i % 11 == 10) asm volatile("" ::: "memory"); }
#pragma unroll
    for (int e = 0; e < 4; ++e) { o4[e] += __shfl_xor(o4[e], 16); o4[e] += __shfl_xor(o4[e], 32); }
    const float inv = __builtin_amdgcn_rcpf(sum);
    if (kg == 0) { u32x2 w; w.x = cvt_pk_bf16(o4[0] * inv, o4[1] * inv); w.y = cvt_pk_bf16(o4[2] * inv, o4[3] * inv); *(u32x2*)(O + row * DM + hq * 64 + 4 * dq) = w; }
}
__device__ __forceinline__ void attn_phase(const Args& A, LAS unsigned char* lds, int jl, int tid, int lane, int wid) {
    const bf16* KFg = (const bf16*)(A.ws + WS_KF); const bf16* VTg = (const bf16*)(A.ws + WS_VT);
    for (int u = blockIdx.x; u < NB * 16 * 4; u += gridDim.x) { const int kvh = u & 3, qb = (u >> 2) & 15, b = u >> 6;
        const size_t bk = (size_t)b * 4 + kvh; const int q0 = qb * 128;
        __syncthreads();
#pragma unroll
        for (int j = 0; j < 4; ++j) { const int ci = tid + 512 * j, row = ci >> 3, part = ci & 7, t = q0 - 128 + row;
            if (t >= 0) *(LAS u32x4*)(lds + L_AK + row * KRS + part * 16) = *(const u32x4*)(KFg + (bk * SEQ + t) * 64 + part * 8); }
#pragma unroll
        for (int j = 0; j < 4; ++j) { const int ci = tid + 512 * j, row = ci >> 2, part = ci & 3, tile = (q0 - 128) / 32 + (row >> 6);
            if (tile >= 0) *(LAS u32x4*)(lds + L_AV + row * VRS + part * 16) = *(const u32x4*)(VTg + ((bk * 64 + tile) * 64 + (row & 63)) * 32 + part * 8); }
        __syncthreads();
        const int hq = kvh * 4 + (wid >> 1), r0 = q0 + (wid & 1) * 64, lt0 = 2 * (wid & 1);
        attn_prompt_tile(A, lds, lt0, jl, b, hq, r0, lane); attn_prompt_tile(A, lds, lt0 + 1, jl, b, hq, r0 + 32, lane); }
    __syncthreads();
    for (int it = blockIdx.x * 8 + wid; it < MS * 16; it += gridDim.x * 8) attn_sample_item(A, jl, it >> 4, it & 15, lane);
}

struct Thin { const bf16* A; const bf16* Wt; int K; int mode; const bf16* XBi; float* Xout; bf16* XBo; float* SSout; const float* SSin; bf16* PP; bf16* Q; float scale; };
typedef float f32x2v __attribute__((ext_vector_type(2)));
__device__ __forceinline__ void thin_gemm(LAS unsigned char* lds, const Thin& T, int tid, int lane, int wid, int bid) {
    if (bid >= 128) return;
    const int rt = bid >> 4, ct = bid & 15, fr = lane & 15, fq = lane >> 4;
    const int kw = T.K >> 3, k0 = wid * kw;
    const bf16* ap = T.A + (size_t)(MP + rt * 16 + fr) * T.K + k0 + 8 * fq;
    const bf16* bp = T.Wt + (size_t)(ct * 64 + fr) * T.K + k0 + 8 * fq;
    f32x4 acc[4];
#pragma unroll
    for (int c = 0; c < 4; ++c) acc[c] = (f32x4){0.f, 0.f, 0.f, 0.f};
#pragma unroll 2
    for (int k = 0; k < kw; k += 32) {
        const bf16x8 av = *(const bf16x8*)(ap + k);
#pragma unroll
        for (int c = 0; c < 4; ++c) { const bf16x8 bv = *(const bf16x8*)(bp + (size_t)c * 16 * T.K + k); acc[c] = __builtin_amdgcn_mfma_f32_16x16x32_bf16(av, bv, acc[c], 0, 0, 0); }
    }
    LAS float* red = (LAS float*)lds;
#pragma unroll
    for (int c = 0; c < 4; ++c)
#pragma unroll
        for (int r = 0; r < 4; ++r) red[(wid * 16 + 4 * fq + r) * 64 + c * 16 + fr] = acc[c][r];
    __syncthreads();
    const int row_l = tid >> 5, c2 = (tid & 31) * 2;
    f32x2v v = (f32x2v){0.f, 0.f};
#pragma unroll
    for (int w = 0; w < 8; ++w) v += *(const LAS f32x2v*)(red + (w * 16 + row_l) * 64 + c2);
    const int row = MP + rt * 16 + row_l, col = ct * 64 + c2; const size_t off = (size_t)row * DM + col;
    if (T.mode <= 1) {
        const unsigned xw = *(const unsigned*)(T.XBi + off); f32x2v x = (f32x2v){bflo(xw), bfhi(xw)};
        if (T.mode == 1) { const float rs = pg8::rstd_row(T.SSin, row); const unsigned pw = *(const unsigned*)(T.PP + off); x[0] += pg8::sigmoid_f(v[0] * rs) * bflo(pw); x[1] += pg8::sigmoid_f(v[1] * rs) * bfhi(pw); }
        else x += v * T.scale;
        float ssq = x[0] * x[0] + x[1] * x[1];
        if (T.Xout) *(f32x2v*)(T.Xout + off) = x;
        *(unsigned*)(T.XBo + off) = cvt_pk_bf16(x[0], x[1]);
        ssq += __shfl_xor(ssq, 1); ssq += __shfl_xor(ssq, 2); ssq += __shfl_xor(ssq, 4); ssq += __shfl_xor(ssq, 8); ssq += __shfl_xor(ssq, 16);
        if ((tid & 31) == 0) T.SSout[(size_t)row * 16 + ct] = ssq;
    } else if (T.mode == 2) { const float rs = pg8::rstd_row(T.SSin, row); *(unsigned*)(T.Q + off) = cvt_pk_bf16(v[0] * rs, v[1] * rs); }
    else *(unsigned*)(T.PP + off) = cvt_pk_bf16(v[0], v[1]);
    __syncthreads();
}

#define GEMM_RUN(EPI, g, E) do { pg8::StaticOrder S_; S_.init((g).M, (g).N, (int)gridDim.x, bid); pg8::gemm_phase<EPI, pg8::StaticOrder, true, true>(lds, (g), S_, (E), tid); } while (0)

__global__ void __launch_bounds__(512, 2) yoco_fwd(Args A_) {
    extern __shared__ __attribute__((aligned(16))) unsigned char lds_raw[];
    LAS unsigned char* lds = (LAS unsigned char*)lds_raw;
    const int wid = __builtin_amdgcn_readfirstlane((int)threadIdx.x >> 6);
    typedef const __attribute__((address_space(4))) Args* CArgsP;
    const int ph_lo = A_.ph_lo, ph_hi = A_.ph_hi;
    volatile LAS unsigned* MISC = (volatile LAS unsigned*)(lds + LDS_BYTES - 64);
    XcdBarrier gbar; gbar.bar = (unsigned*)(A_.ws + WS_BAR); gbar.x = 0; gbar.st = MISC;
    if (ph_hi - ph_lo > 1) {
        const int tid0 = (int)threadIdx.x;
        if (tid0 < 16) MISC[tid0] = 0u;
        __syncthreads();
        gbar = xcd_barrier_post((unsigned*)(A_.ws + WS_BAR), MISC, tid0);
    }
    for (int ph = ph_lo; ph < ph_hi; ++ph) {
        unsigned ones = ~0u; asm volatile("" : "+s"(ones));
        int lane_l = __builtin_amdgcn_mbcnt_hi(ones, __builtin_amdgcn_mbcnt_lo(ones, 0u)); asm volatile("" : "+v"(lane_l));
        CArgsP ap = (CArgsP)__builtin_amdgcn_kernarg_segment_ptr(); asm volatile("" : "+s"(ap));
        const Args& A = *(const Args*)ap;
        const int lane = lane_l, tid = wid * 64 + lane;
        int bid = (int)blockIdx.x; asm volatile("" : "+s"(bid));
        unsigned char* ws = A.ws;
        bf16* Hb = (bf16*)(ws + WS_H); bf16* PPb = (bf16*)(ws + WS_PP);
        unsigned long long tail_mask = 0ull; int tail_nwg = 0;
        if (ph == 0) { p0_prologue(A, lds, tid, lane, wid); }
        else {
            int L, s;
            if (ph <= 20) { L = (ph - 1) / 10; const int t = (ph - 1) % 10; s = t < 3 ? t : (t == 3 ? 9 : t - 1); } else { const int q = ph - 21; L = 2 + q / 8; s = q % 8; s = s < 4 ? s : s + 1; }
            const bool isA = L < 2; const int jl = L - 2;
            bf16* XB = (bf16*)(ws + ((L & 1) ? WS_XB2 : WS_XB)); bf16* XBn = (bf16*)(ws + ((L & 1) ? WS_XB : WS_XB2));
            float* SS0 = (float*)(ws + WS_SS); float* SS1 = (float*)(ws + WS_SS2);
            unsigned char* wl = ws + WS_W + (size_t)L * WL_STRIDE;
            if (s == 0 || s == 6) {
                pg8::Gemm g{XB, (const bf16*)(wl + (s == 0 ? WL_WI1 : WL_WI2)), MPAD, 2 * DFF, DM};
                pg8::EpiSwiGLU E{Hb, DFF, SS0};
                GEMM_RUN(pg8::EpiSwiGLU, g, E);
                tail_mask = tail_jobs(L, s); tail_nwg = (MPAD / 256) * (2 * DFF / 256);
                if (s == 0 && L == 2) {
                    pg8::Gemm g2{XB, (const bf16*)(ws + WS_WKV), MPAD, 512, DM};
                    pg8::EpiF32 E2{(float*)(ws + WS_KVRAW), 512, SS0, nullptr};
                    GEMM_RUN(pg8::EpiF32, g2, E2);
                }
            } else if (s == 1 || s == 7) {
                if (s == 1 && L == 2) kv_finalize(A, lane, wid);
                pg8::Gemm g{Hb, (const bf16*)(wl + (s == 1 ? WL_WO1 : WL_WO2)), MP, DM, DFF};
                pg8::EpiRes E{XB, nullptr, XB, SS1, nullptr, nullptr, 0.5f, 0, MPAD};
                GEMM_RUN(pg8::EpiRes, g, E);
                Thin T{Hb, g.Bt, DFF, 0, XB, nullptr, XB, SS1, nullptr, nullptr, nullptr, 0.5f};
                thin_gemm(lds, T, tid, lane, wid, bid);
            } else if (s == 2) {
                if (isA) { pg8::Gemm g{XB, (const bf16*)(ws + WS_WA + (size_t)L * WA_STRIDE + WA_WIN), MPAD, NINP, DM};
                    pg8::EpiSplit E{(bf16*)(ws + WS_Z), DIN, 8, (bf16*)(ws + WS_XBC), CONVD, 24, (float*)(ws + WS_DT), SS1};
                    GEMM_RUN(pg8::EpiSplit, g, E);
                    tail_mask = tail_jobs(L, s); tail_nwg = (MPAD / 256) * (NINP / 256);
                } else { pg8::Gemm g{XB, (const bf16*)(ws + WS_WB + (size_t)jl * WB_STRIDE + WB_WQ), MP, DM, DM};
                    pg8::EpiSplit E{(bf16*)(ws + WS_Q), DM, 4, (bf16*)(ws + WS_Q), DM, 4, (float*)(ws + WS_DT), SS1};
                    GEMM_RUN(pg8::EpiSplit, g, E);
                    Thin T{XB, g.Bt, DM, 2, nullptr, nullptr, nullptr, nullptr, SS1, nullptr, (bf16*)(ws + WS_Q), 1.0f};
                    thin_gemm(lds, T, tid, lane, wid, bid); }
            } else if (s == 3) {
                if (isA) ssd_phase(A, lds, L, tid, lane, wid); else attn_phase(A, lds, jl, tid, lane, wid);
            } else if (s == 9) {
                ssd_pre_phase(A, L, tid, lane, wid);
            } else if (s == 4) {
                if (isA) gnorm_phase(A, tid);
            } else if (s == 5) {
                pg8::Gemm g{isA ? (const bf16*)(ws + WS_YG) : (const bf16*)(ws + WS_O), isA ? (const bf16*)(ws + WS_WA + (size_t)L * WA_STRIDE + WA_WOUT) : (const bf16*)(ws + WS_WB + (size_t)jl * WB_STRIDE + WB_WO), MP, DM, isA ? DIN : DM};
                pg8::EpiRes E{XB, nullptr, XB, SS0, nullptr, nullptr, 1.0f, 0, MPAD};
                GEMM_RUN(pg8::EpiRes, g, E);
                Thin T{g.A, g.Bt, g.K, 0, XB, nullptr, XB, SS0, nullptr, nullptr, nullptr, 1.0f};
                thin_gemm(lds, T, tid, lane, wid, bid);
            } else {
                pg8::Gemm g1{(const bf16*)(ws + WS_P16) + (size_t)L * MPAD * DPLE, (const bf16*)(wl + WL_WP), MP, DM, DPLE};
                pg8::EpiF32 E1{nullptr, DM, nullptr, PPb};
                GEMM_RUN(pg8::EpiF32, g1, E1);
                pg8::Gemm g2{XB, (const bf16*)(wl + WL_WG), MP, DM, DM};
                const bool last = (L == NLAYER - 1);
                float* xo = last ? A.out + O_Y : nullptr;
                pg8::EpiRes E2{XB, xo, XBn, SS0, SS1, PPb, 1.0f, 1, MPAD};
                GEMM_RUN(pg8::EpiRes, g2, E2);
                Thin T1{g1.A, g1.Bt, DPLE, 3, nullptr, nullptr, nullptr, nullptr, nullptr, PPb, nullptr, 1.0f};
                thin_gemm(lds, T1, tid, lane, wid, bid);
                Thin T2{XB, g2.Bt, DM, 1, XB, xo, XBn, SS0, SS1, PPb, nullptr, 1.0f};
                thin_gemm(lds, T2, tid, lane, wid, bid);
            }
        }
        if (ph > 0 && tail_mask) {
            const int G = (int)gridDim.x, rem = tail_nwg % G;
            if (rem != 0 && bid >= rem) convert_weights(A, lds, lane, wid, tail_mask, (bid - rem) * 8 + wid, (G - rem) * 8);
        }
        if (ph + 1 < ph_hi) {
            if (ph_hi < 0) cg::this_grid().sync();
            xcd_barrier(gbar, tid);
        }
    }
}

extern "C" void kernel_launch(void* const* d_in, const int* in_sizes, int n_in, void* d_out, int out_size, void* d_ws, size_t ws_size, hipStream_t stream) {
    static int grid = 0;
    if (grid == 0) {
        if (n_in != 33 || ws_size < WS_END) { fprintf(stderr, "kernel_launch: unexpected n_in %d or ws_size %zu (need %zu)\n", n_in, ws_size, (size_t)WS_END); grid = -1; return; }
        int dev = 0, cus = 0, per_cu = 0;
        hipGetDevice(&dev); hipDeviceGetAttribute(&cus, hipDeviceAttributeMultiprocessorCount, dev);
        if (hipFuncSetAttribute((const void*)yoco_fwd, hipFuncAttributeMaxDynamicSharedMemorySize, LDS_BYTES) != hipSuccess) { fprintf(stderr, "kernel_launch: hipFuncSetAttribute failed\n"); grid = -1; return; }
        if (hipOccupancyMaxActiveBlocksPerMultiprocessor(&per_cu, (const void*)yoco_fwd, 512, LDS_BYTES) != hipSuccess || per_cu < 1) { fprintf(stderr, "kernel_launch: occupancy query says %d\n", per_cu); per_cu = 1; }
        (void)hipGetLastError();
        grid = cus * 1;
        if (grid <= 0) grid = 256;
    }
    if (grid < 0) return;
    Args a{};
    for (int i = 0; i < 33; ++i) a.in[i] = (const float*)d_in[i];
    a.out = (float*)d_out; a.ws = (unsigned char*)d_ws;
#if MK_MULTI
    for (int ph = 0; ph < NPHASE; ++ph) {
        a.ph_lo = ph; a.ph_hi = ph + 1;
        hipLaunchKernelGGL(yoco_fwd, dim3(grid), dim3(512), LDS_BYTES, stream, a);
    }
#else
    (void)hipMemsetAsync((unsigned char*)d_ws + WS_BAR, 0, BAR_BYTES, stream);
    a.ph_lo = 0; a.ph_hi = NPHASE;
    void* args[] = {&a};
    hipError_t e = hipLaunchCooperativeKernel((const void*)yoco_fwd, dim3(grid), dim3(512), args, LDS_BYTES, stream);
    if (e != hipSuccess) fprintf(stderr, "cooperative launch failed: %s (grid %d)\n", hipGetErrorString(e), grid);
#endif
}
```
